# Optimizing an MI355X kernel written in HIP

```python
import math
import jax
import jax.numpy as jnp
from jax import lax
import numpy as np

D_MODEL = 1024
BATCH = 4
SEQ = 8192
DEPTH = 2

GRID_W = 64
CTX_LEN = 256
HEAD_DIM = 64
GROUP_WIDTH = D_MODEL // 4
MIX_WIDTH = 4 * GROUP_WIDTH
GROUP_HEADS = GROUP_WIDTH // HEAD_DIM
GQA_KV_HEADS = 2
GQA_Q_PER_KV = GROUP_HEADS // GQA_KV_HEADS
DIFF_QK_DIM = HEAD_DIM // 2
HGRN_KEY_DIM = HEAD_DIM
SCAN_CHUNK = 64
Q_BLOCK = 128
ROPE_BASE = 10000.0
N_EXPERTS = 32
N_EXPERT_GROUPS = 8
EXPERTS_PER_GROUP = N_EXPERTS // N_EXPERT_GROUPS
TOP_K = 2
EXPERT_FF = 512
MOE_BLOCK = 256
NORM_EPS = 1e-6
IN_SPLITS = (
    GROUP_WIDTH, GROUP_WIDTH, GROUP_WIDTH, GROUP_WIDTH,
    GROUP_WIDTH, GQA_KV_HEADS * HEAD_DIM, GQA_KV_HEADS * HEAD_DIM,
    GROUP_WIDTH, GROUP_WIDTH, GROUP_WIDTH, GROUP_WIDTH, GROUP_WIDTH,
    GROUP_WIDTH, GROUP_WIDTH, GROUP_WIDTH,
)
IN_WIDTH = sum(IN_SPLITS)

kernel_name = 'hybrid_prefix_diffusion_block'


def rms_norm(x, gain):
    xf = x.astype(jnp.float32)
    y = xf * lax.rsqrt(jnp.mean(xf * xf, axis=-1, keepdims=True) + NORM_EPS)
    return (y * gain.astype(jnp.float32)).astype(x.dtype)


def modulate(x, shift, scale):
    return x * (1 + scale) + shift


def split_heads(a, n_heads):
    return a.reshape(*a.shape[:-1], n_heads, a.shape[-1] // n_heads)


def split_columns(z):
    idx, acc = [], 0
    for w in IN_SPLITS[:-1]:
        acc += w
        idx.append(acc)
    return jnp.split(z, idx, axis=-1)


def axial_rope(rows, rot_dim):
    n_freq = rot_dim // 4
    inv_freq = ROPE_BASE ** (-jnp.arange(n_freq, dtype=jnp.float32) / n_freq)
    row = jnp.broadcast_to(jnp.arange(rows, dtype=jnp.float32)[:, None], (rows, GRID_W)).reshape(-1)
    col = jnp.broadcast_to(jnp.arange(GRID_W, dtype=jnp.float32)[None, :], (rows, GRID_W)).reshape(-1)
    ang = jnp.concatenate([row[:, None] * inv_freq, col[:, None] * inv_freq], axis=-1)
    return jnp.cos(ang), jnp.sin(ang)


def apply_rope(x, cos, sin):
    shape = (cos.shape[0],) + (1,) * (x.ndim - 3) + (cos.shape[-1],)
    cs, sn = cos.reshape(shape), sin.reshape(shape)
    half = x.shape[-1] // 2
    xf = x.astype(jnp.float32)
    x1, x2 = xf[..., :half], xf[..., half:]
    return jnp.concatenate([x1 * cs - x2 * sn, x2 * cs + x1 * sn], axis=-1).astype(x.dtype)


def sweep_query_blocks(fn, q):
    b, t = q.shape[:2]
    nb = t // Q_BLOCK
    qb = jnp.moveaxis(q.reshape(b, nb, Q_BLOCK, *q.shape[2:]), 1, 0)
    ob = lax.map(fn, qb)
    return jnp.moveaxis(ob, 0, 1).reshape(b, t, *ob.shape[3:])


def gqa_attention(q, k, v):
    scale = q.shape[-1] ** -0.5

    def block(qb):
        s = jnp.einsum('bqhgd,bshd->bhgqs', qb, k, preferred_element_type=jnp.float32) * scale
        p = jax.nn.softmax(s, axis=-1).astype(v.dtype)
        return jnp.einsum('bhgqs,bshd->bqhgd', p, v)
    return sweep_query_blocks(block, q)


def differential_attention(q, k, v, lam):
    scale = q.shape[-1] ** -0.5

    def block(qb):
        s = jnp.einsum('bqhmd,bshmd->bhmqs', qb, k, preferred_element_type=jnp.float32) * scale
        p = jax.nn.softmax(s, axis=-1)
        w = (p[:, :, 0] - lam * p[:, :, 1]).astype(v.dtype)
        return jnp.einsum('bhqs,bshd->bqhd', w, v)
    return sweep_query_blocks(block, q)


def linear_recurrence(q, k, v, log_a, s0):
    b, h, t, _ = q.shape
    dv = v.shape[-1]
    n = t // SCAN_CHUNK

    def to_chunks(a):
        return jnp.moveaxis(a.reshape(b, h, n, SCAN_CHUNK, a.shape[-1]), 2, 0)
    causal = jnp.tril(jnp.ones((SCAN_CHUNK, SCAN_CHUNK), bool))[:, :, None]

    def step(state, inp):
        qc, kc, vc, lac = inp
        qf, kf, vf = qc.astype(jnp.float32), kc.astype(jnp.float32), vc.astype(jnp.float32)
        cum = jnp.cumsum(lac.astype(jnp.float32), axis=2)
        o_inter = jnp.einsum('bhtd,bhdv->bhtv', qf * jnp.exp(cum), state)
        rel = cum[:, :, :, None, :] - cum[:, :, None, :, :]
        decay = jnp.where(causal, jnp.exp(jnp.where(causal, rel, 0.0)), 0.0)
        scores = jnp.einsum('bhtd,bhsd,bhtsd->bhts', qf, kf, decay)
        o_intra = jnp.einsum('bhts,bhsv->bhtv', scores, vf)
        last = cum[:, :, -1:, :]
        new_state = jnp.exp(last[:, :, 0, :, None]) * state + jnp.einsum(
            'bhsd,bhsv->bhdv', kf * jnp.exp(last - cum), vf)
        return new_state, o_inter + o_intra

    s_t, o = lax.scan(step, s0.astype(jnp.float32),
                      (to_chunks(q), to_chunks(k), to_chunks(v), to_chunks(log_a)))
    o = jnp.moveaxis(o, 0, 2).reshape(b, h, t, dv)
    return o.astype(v.dtype), s_t


def two_way_prefix_scan(lat, ctx):
    def flip(a):
        return jnp.flip(a, axis=2)
    q, kf, kb, v, af, ab = lat
    qc, kcf, kcb, vc, acf, acb = ctx
    s0 = jnp.zeros((q.shape[0], q.shape[1], q.shape[-1], v.shape[-1]), jnp.float32)
    oc_f, s_f = linear_recurrence(qc, kcf, vc, acf, s0)
    oc_b, s_b = linear_recurrence(flip(qc), flip(kcb), flip(vc), flip(acb), s0)
    o_f, _ = linear_recurrence(q, kf, v, af, s_f)
    o_b, _ = linear_recurrence(flip(q), flip(kb), flip(v), flip(ab), s_b)
    return o_f + flip(o_b), oc_f + flip(oc_b)


def retention_mixer(parts, parts_c, decay_logit, norm_g, rope, need_ctx):
    def prep(p, rotate):
        q, k, v, g = p
        q = split_heads(q, GROUP_HEADS) * HEAD_DIM ** -0.5
        k = split_heads(k, GROUP_HEADS)
        if rotate:
            q, k = apply_rope(q, *rope), apply_rope(k, *rope)
        return (jnp.swapaxes(q, 1, 2), jnp.swapaxes(k, 1, 2),
                jnp.swapaxes(split_heads(v, GROUP_HEADS), 1, 2), g)
    q, k, v, g = prep(parts, True)
    qc, kc, vc, gc = prep(parts_c, False)
    log_gamma = jax.nn.log_sigmoid(decay_logit.astype(jnp.float32))[:, None, :, None, None]

    def log_decay(a, direction):
        return jnp.broadcast_to(log_gamma[direction], a.shape)
    o, oc = two_way_prefix_scan((q, k, k, v, log_decay(k, 0), log_decay(k, 1)),
                                (qc, kc, kc, vc, log_decay(kc, 0), log_decay(kc, 1)))

    def readout(o_, g_):
        return rms_norm(jnp.swapaxes(o_, 1, 2), norm_g).reshape(g_.shape) * jax.nn.silu(g_)
    return readout(o, g), (readout(oc, gc) if need_ctx else None)


def hgrn2_mixer(parts, parts_c, lower_bound, norm_g, need_ctx):
    lb = lower_bound.astype(jnp.float32).reshape(2, GROUP_HEADS, 1, HGRN_KEY_DIM)

    def bhtd(a):
        return jnp.swapaxes(split_heads(a, GROUP_HEADS), 1, 2)

    def gate(z, d):
        z = bhtd(z).astype(jnp.float32)
        f = lb[d] + (1 - lb[d]) * jax.nn.sigmoid(z)
        return (1 - lb[d]) * jax.nn.sigmoid(-z), jnp.log(f)

    def prep(p):
        q, zf, zb, i, g = p
        k_f, lf_f = gate(zf, 0)
        k_b, lf_b = gate(zb, 1)
        return (bhtd(q), k_f, k_b, bhtd(i), lf_f, lf_b), g
    lat, g = prep(parts)
    ctx, gc = prep(parts_c)
    o, oc = two_way_prefix_scan(lat, ctx)

    def readout(o_, g_):
        return rms_norm(jnp.swapaxes(o_, 1, 2), norm_g).reshape(g_.shape) * jax.nn.silu(g_)
    return readout(o, g), (readout(oc, gc) if need_ctx else None)


def gqa_mixer(parts, parts_c, qn_g, kn_g, rope, need_ctx):
    def prep(p, rotate):
        q, k, v = p
        q = rms_norm(split_heads(q, GROUP_HEADS), qn_g)
        k = rms_norm(split_heads(k, GQA_KV_HEADS), kn_g)
        if rotate:
            q, k = apply_rope(q, *rope), apply_rope(k, *rope)
        q = q.reshape(*q.shape[:2], GQA_KV_HEADS, GQA_Q_PER_KV, HEAD_DIM)
        return q, k, split_heads(v, GQA_KV_HEADS)
    q, k, v = prep(parts, True)
    qc, kc, vc = prep(parts_c, False)
    k_all = jnp.concatenate([kc, k], axis=1)
    v_all = jnp.concatenate([vc, v], axis=1)

    def flat(o_):
        return o_.reshape(*o_.shape[:2], GROUP_WIDTH)
    o = flat(gqa_attention(q, k_all, v_all))
    return o, (flat(gqa_attention(qc, kc, vc)) if need_ctx else None)


def diff_mixer(parts, parts_c, lam_params, norm_g, lambda_init, rope, need_ctx):
    def prep(p, rotate):
        q, k, v = p
        q = q.reshape(*q.shape[:-1], GROUP_HEADS, 2, DIFF_QK_DIM)
        k = k.reshape(*k.shape[:-1], GROUP_HEADS, 2, DIFF_QK_DIM)
        if rotate:
            q, k = apply_rope(q, *rope), apply_rope(k, *rope)
        return q, k, split_heads(v, GROUP_HEADS)
    lp = lam_params.astype(jnp.float32)
    lam = jnp.exp(jnp.sum(lp[0] * lp[1])) - jnp.exp(jnp.sum(lp[2] * lp[3])) + lambda_init
    q, k, v = prep(parts, True)
    qc, kc, vc = prep(parts_c, False)
    k_all = jnp.concatenate([kc, k], axis=1)
    v_all = jnp.concatenate([vc, v], axis=1)

    def readout(o_):
        return (rms_norm(o_, norm_g) * (1 - lambda_init)).reshape(*o_.shape[:2], GROUP_WIDTH)
    o = readout(differential_attention(q, k_all, v_all, lam))
    return o, (readout(differential_attention(qc, kc, vc, lam)) if need_ctx else None)


def routed_moe(h, router_w, router_bias, w_gate, w_up, w_down):
    n, d = h.shape
    scores = jax.nn.sigmoid(jnp.dot(h, router_w, preferred_element_type=jnp.float32))
    sel = (scores + router_bias.astype(jnp.float32)).reshape(n, N_EXPERT_GROUPS, EXPERTS_PER_GROUP)
    group_score = lax.top_k(sel, 2)[0].sum(-1)
    best_group = jnp.argmax(group_score, axis=-1)
    in_group = sel[jnp.arange(n), best_group]
    _, local = lax.top_k(in_group, TOP_K)
    expert = best_group[:, None] * EXPERTS_PER_GROUP + local
    gate = jnp.take_along_axis(scores, expert, axis=1)
    gate = gate / jnp.sum(gate, axis=-1, keepdims=True)

    m = n * TOP_K
    e_flat = expert.reshape(m)
    tok = jnp.repeat(jnp.arange(n), TOP_K)
    order = jnp.argsort(e_flat)
    e_s, tok_s, w_s = e_flat[order], tok[order], gate.reshape(m)[order]
    counts = jnp.bincount(e_flat, length=N_EXPERTS)
    padded = (counts + MOE_BLOCK - 1) // MOE_BLOCK * MOE_BLOCK
    start = jnp.cumsum(counts) - counts
    pend = jnp.cumsum(padded)
    pstart = pend - padded
    dest = pstart[e_s] + jnp.arange(m) - start[e_s]
    n_blocks = -(-m // MOE_BLOCK) + N_EXPERTS
    rows = n_blocks * MOE_BLOCK
    xs = jnp.zeros((rows, d), h.dtype).at[dest].set(h[tok_s])
    block_expert = jnp.clip(jnp.searchsorted(pend, jnp.arange(n_blocks) * MOE_BLOCK, side='right'),
                            0, N_EXPERTS - 1)

    def expert_block(args):
        xb, e = args
        a = jnp.dot(xb, w_gate[e])
        u = jnp.dot(xb, w_up[e])
        return jnp.dot(jax.nn.silu(a) * u, w_down[e])
    ys = lax.map(expert_block, (xs.reshape(n_blocks, MOE_BLOCK, d), block_expert)).reshape(rows, d)
    y = jnp.zeros((n, d), jnp.float32).at[tok_s].add(ys[dest].astype(jnp.float32) * w_s[:, None])
    return y.astype(h.dtype)


def trunk_layer(layer, x, xc, c, c_ctx, rope_hd, rope_diff, w_mod, b_mod, norm1_g, norm2_g,
                w_in, ret_decay_logit, ret_norm_g, gqa_qnorm_g, gqa_knorm_g, hgrn_lower_bound,
                hgrn_norm_g, diff_lambda, diff_norm_g, w_out, router_w, router_bias,
                moe_w_gate, moe_w_up, moe_w_down, need_ctx):
    b, t, d = x.shape
    mod = jnp.dot(jax.nn.silu(c), w_mod) + b_mod
    mod_c = jnp.dot(jax.nn.silu(c_ctx), w_mod) + b_mod
    sh1, sc1, g1, sh2, sc2, g2 = jnp.split(mod[:, None, :], 6, axis=-1)
    sh1c, sc1c, g1c, sh2c, sc2c, g2c = jnp.split(mod_c, 6, axis=-1)

    h = modulate(rms_norm(x, norm1_g), sh1, sc1)
    hc = modulate(rms_norm(xc, norm1_g), sh1c, sc1c)
    p = split_columns(jnp.dot(h, w_in))
    pc = split_columns(jnp.dot(hc, w_in))
    lambda_init = 0.8 - 0.6 * math.exp(-0.3 * layer)
    o_ret, oc_ret = retention_mixer(p[0:4], pc[0:4], ret_decay_logit, ret_norm_g, rope_hd, need_ctx)
    o_gqa, oc_gqa = gqa_mixer(p[4:7], pc[4:7], gqa_qnorm_g, gqa_knorm_g, rope_hd, need_ctx)
    o_hg, oc_hg = hgrn2_mixer(p[7:12], pc[7:12], hgrn_lower_bound, hgrn_norm_g, need_ctx)
    o_df, oc_df = diff_mixer(p[12:15], pc[12:15], diff_lambda, diff_norm_g, lambda_init,
                             rope_diff, need_ctx)
    x = x + g1 * jnp.dot(jnp.concatenate([o_ret, o_gqa, o_hg, o_df], axis=-1), w_out)
    h2 = modulate(rms_norm(x, norm2_g), sh2, sc2).reshape(b * t, d)
    if not need_ctx:
        y = routed_moe(h2, router_w, router_bias, moe_w_gate, moe_w_up, moe_w_down)
        return x + g2 * y.reshape(b, t, d), xc
    xc = xc + g1c * jnp.dot(jnp.concatenate([oc_ret, oc_gqa, oc_hg, oc_df], axis=-1), w_out)
    h2c = modulate(rms_norm(xc, norm2_g), sh2c, sc2c).reshape(-1, d)
    y = routed_moe(jnp.concatenate([h2, h2c], axis=0), router_w, router_bias,
                   moe_w_gate, moe_w_up, moe_w_down)
    x = x + g2 * y[:b * t].reshape(b, t, d)
    xc = xc + g2c * y[b * t:].reshape(xc.shape)
    return x, xc


def setup_inputs(seed: int = 0) -> dict:
    key = jax.random.key(seed)
    ks = jax.random.split(key, 24)

    def nrm(k, shape, s):
        return jax.random.normal(k, shape, jnp.float32) * s
    gamma = 1.0 - jnp.exp2(-5.0 - jnp.arange(GROUP_HEADS, dtype=jnp.float32))
    ret_logit = jnp.log(gamma) - jnp.log1p(-gamma)
    return {
        'x': nrm(ks[0], (BATCH, SEQ, D_MODEL), 1.0),
        'c': nrm(ks[1], (BATCH, D_MODEL), 1.0),
        'ctx': nrm(ks[2], (BATCH, CTX_LEN, D_MODEL), 1.0),
        'c_ctx': nrm(ks[3], (D_MODEL,), 1.0),
        'w_mod': nrm(ks[4], (DEPTH, D_MODEL, 6 * D_MODEL), 0.5 * D_MODEL ** -0.5),
        'b_mod': nrm(ks[5], (DEPTH, 6 * D_MODEL), 0.01),
        'norm1_g': 1.0 + nrm(ks[6], (DEPTH, D_MODEL), 0.02),
        'norm2_g': 1.0 + nrm(ks[7], (DEPTH, D_MODEL), 0.02),
        'w_in': nrm(ks[8], (DEPTH, D_MODEL, IN_WIDTH), D_MODEL ** -0.5),
        'ret_decay_logit': ret_logit + nrm(ks[9], (DEPTH, 2, GROUP_HEADS), 0.1),
        'ret_norm_g': 1.0 + nrm(ks[10], (DEPTH, HEAD_DIM), 0.02),
        'gqa_qnorm_g': 1.0 + nrm(ks[11], (DEPTH, HEAD_DIM), 0.02),
        'gqa_knorm_g': 1.0 + nrm(ks[12], (DEPTH, HEAD_DIM), 0.02),
        'hgrn_lb_logit': nrm(ks[13], (2, DEPTH, GROUP_WIDTH), 0.5),
        'hgrn_norm_g': 1.0 + nrm(ks[14], (DEPTH, HEAD_DIM), 0.02),
        'diff_lambda': nrm(ks[15], (DEPTH, 4, DIFF_QK_DIM), 0.1),
        'diff_norm_g': 1.0 + nrm(ks[16], (DEPTH, HEAD_DIM), 0.02),
        'w_out': nrm(ks[17], (DEPTH, MIX_WIDTH, D_MODEL), MIX_WIDTH ** -0.5),
        'router_w': nrm(ks[18], (D_MODEL, N_EXPERTS), D_MODEL ** -0.5),
        'router_bias': nrm(ks[19], (N_EXPERTS,), 0.01),
        'moe_w_gate': nrm(ks[20], (DEPTH, N_EXPERTS, D_MODEL, EXPERT_FF), D_MODEL ** -0.5),
        'moe_w_up': nrm(ks[21], (DEPTH, N_EXPERTS, D_MODEL, EXPERT_FF), D_MODEL ** -0.5),
        'moe_w_down': nrm(ks[22], (DEPTH, N_EXPERTS, EXPERT_FF, D_MODEL), EXPERT_FF ** -0.5),
        'final_norm_g': 1.0 + nrm(ks[23], (D_MODEL,), 0.02),
    }


def reference(x, c, ctx, c_ctx, w_mod, b_mod, norm1_g, norm2_g, w_in, ret_decay_logit,
              ret_norm_g, gqa_qnorm_g, gqa_knorm_g, hgrn_lb_logit, hgrn_norm_g, diff_lambda,
              diff_norm_g, w_out, router_w, router_bias, moe_w_gate, moe_w_up, moe_w_down,
              final_norm_g):
    n_tokens = x.shape[1]
    rows = n_tokens // GRID_W
    rope_hd = axial_rope(rows, HEAD_DIM)
    rope_diff = axial_rope(rows, DIFF_QK_DIM)
    sm = jax.nn.softmax(hgrn_lb_logit.astype(jnp.float32), axis=1)
    lower_bounds = jnp.cumsum(sm, axis=1) - sm[:, :1]
    xc = ctx
    for layer in range(DEPTH):
        x, xc = trunk_layer(
            layer, x, xc, c, c_ctx, rope_hd, rope_diff, w_mod[layer], b_mod[layer],
            norm1_g[layer], norm2_g[layer], w_in[layer], ret_decay_logit[layer],
            ret_norm_g[layer], gqa_qnorm_g[layer], gqa_knorm_g[layer], lower_bounds[:, layer],
            hgrn_norm_g[layer], diff_lambda[layer], diff_norm_g[layer], w_out[layer],
            router_w, router_bias, moe_w_gate[layer], moe_w_up[layer], moe_w_down[layer],
            layer < DEPTH - 1)
    return rms_norm(x, final_norm_g)
```

```cpp
#include <hip/hip_runtime.h>
#include <stdint.h>
#include <math.h>

#define DM 1024
#define NB 4
#define SEQ 8192
#define CTX 256
#define NLAT (NB * SEQ)
#define NCTX (NB * CTX)
#define NTOK (NLAT + NCTX)
#define RB (SEQ + CTX)
#define INW 3584
#define NE 32
#define FF 512
#define RMAX 75776

struct P {
    const float *x, *c, *ctx, *c_ctx, *w_mod, *b_mod, *n1g, *n2g, *w_in, *ret_dl, *ret_ng, *gq_g, *gk_g, *hg_lb, *hg_ng,
        *df_lam, *df_ng, *w_out, *r_w, *r_b, *wg, *wu, *wd, *fin_g;
    float* out;
    float *modv, *lbv, *gam, *lam;
    float *X, *Hb, *Zb, *OFB, *MIX, *H2, *ACT, *roww, *gw;
    int *cnt, *fill, *pstart, *blkexp, *rowtok, *eid;
};

__device__ __forceinline__ float siluf(float v) { return v / (1.f + expf(-v)); }
__device__ __forceinline__ float sigmf(float v) { return 1.f / (1.f + expf(-v)); }
__device__ __forceinline__ float wave_sum(float v) {
#pragma unroll
    for (int o = 32; o > 0; o >>= 1) v += __shfl_xor(v, o);
    return v;
}
__device__ __forceinline__ int tok_of(int b, int r) { return r < SEQ ? b * SEQ + r : NLAT + b * CTX + (r - SEQ); }
__device__ __forceinline__ int mods_of_tok(int m) { return m < NLAT ? m / SEQ : 4; }

__global__ void k_setup(P p) {
    const int gid = blockIdx.x * blockDim.x + threadIdx.x;
    if (gid < 2 * 6144) {
        const int l = gid / 6144, n = gid % 6144;
        float acc[5];
        for (int s = 0; s < 5; ++s) acc[s] = p.b_mod[l * 6144 + n];
        const float* w = p.w_mod + (size_t)l * 1024 * 6144 + n;
        for (int k = 0; k < 1024; ++k) {
            const float wv = w[(size_t)k * 6144];
            for (int s = 0; s < 4; ++s) acc[s] += siluf(p.c[s * 1024 + k]) * wv;
            acc[4] += siluf(p.c_ctx[k]) * wv;
        }
        for (int s = 0; s < 5; ++s) p.modv[(size_t)(l * 5 + s) * 6144 + n] = acc[s];
    }
    if (gid < 1024) {
        const int l = gid >> 9, dir = (gid >> 8) & 1, w = gid & 255;
        const float x0 = p.hg_lb[(dir * 2 + 0) * 256 + w], x1 = p.hg_lb[(dir * 2 + 1) * 256 + w];
        const float mx = fmaxf(x0, x1), e0 = expf(x0 - mx), e1 = expf(x1 - mx);
        p.lbv[(l * 2 + dir) * 256 + w] = (l == 0) ? 0.f : e1 / (e0 + e1);
    }
    if (gid < 16) p.gam[gid] = sigmf(p.ret_dl[gid]);
    if (gid < 2) {
        const int l = gid;
        float s01 = 0.f, s23 = 0.f;
        for (int d = 0; d < 32; ++d) {
            s01 += p.df_lam[(l * 4 + 0) * 32 + d] * p.df_lam[(l * 4 + 1) * 32 + d];
            s23 += p.df_lam[(l * 4 + 2) * 32 + d] * p.df_lam[(l * 4 + 3) * 32 + d];
        }
        const float li = 0.8f - 0.6f * expf(-0.3f * (float)l);
        p.lam[l * 2] = expf(s01) - expf(s23) + li;
        p.lam[l * 2 + 1] = li;
    }
}

__global__ void k_rowprep(P p, int l, int b) {
    const int wv = (blockIdx.x * blockDim.x + threadIdx.x) >> 6, lane = threadIdx.x & 63, nw = (gridDim.x * blockDim.x) >> 6;
    for (int r = wv; r < RB; r += nw) {
        const int m = tok_of(b, r), s = r < SEQ ? b : 4;
        const float* xr = p.X + (size_t)m * 1024;
        float v[16], ss = 0.f;
#pragma unroll
        for (int j = 0; j < 16; ++j) { v[j] = xr[lane + 64 * j]; ss += v[j] * v[j]; }
        ss = wave_sum(ss);
        const float rstd = 1.0f / sqrtf(ss * (1.f / 1024.f) + 1e-6f);
        const float* mv = p.modv + (size_t)(l * 5 + s) * 6144;
#pragma unroll
        for (int j = 0; j < 16; ++j) {
            const int k = lane + 64 * j;
            p.Hb[(size_t)r * 1024 + k] = v[j] * rstd * p.n1g[l * 1024 + k] * (1.f + mv[1024 + k]) + mv[k];
        }
    }
}

template <bool DUAL, class AF, class BF, class EF>
__device__ __forceinline__ void gemm_tile(int m0, int n0, int K, const AF& af, const BF& bf, const EF& ef) {
    __shared__ float As[16][68];
    __shared__ float Bs[16][68];
    __shared__ float Bs2[DUAL ? 16 : 1][68];
    const int tid = threadIdx.x, tx = tid & 15, ty = tid >> 4;
    float acc[4][4], acc2[4][4];
#pragma unroll
    for (int i = 0; i < 4; ++i)
#pragma unroll
        for (int j = 0; j < 4; ++j) { acc[i][j] = 0.f; acc2[i][j] = 0.f; }
    for (int k0 = 0; k0 < K; k0 += 16) {
#pragma unroll
        for (int i = 0; i < 4; ++i) {
            const int idx = tid + i * 256, mm = idx >> 4, kk = idx & 15;
            As[kk][mm] = af(m0 + mm, k0 + kk);
        }
#pragma unroll
        for (int i = 0; i < 4; ++i) {
            const int idx = tid + i * 256, kk = idx >> 6, nn = idx & 63;
            Bs[kk][nn] = bf(k0 + kk, n0 + nn, 0);
            if (DUAL) Bs2[kk][nn] = bf(k0 + kk, n0 + nn, 1);
        }
        __syncthreads();
#pragma unroll
        for (int kk = 0; kk < 16; ++kk) {
            float a[4], bb[4], b2[4];
#pragma unroll
            for (int i = 0; i < 4; ++i) a[i] = As[kk][ty * 4 + i];
#pragma unroll
            for (int j = 0; j < 4; ++j) { bb[j] = Bs[kk][tx * 4 + j]; b2[j] = DUAL ? Bs2[kk][tx * 4 + j] : 0.f; }
#pragma unroll
            for (int i = 0; i < 4; ++i)
#pragma unroll
                for (int j = 0; j < 4; ++j) { acc[i][j] += a[i] * bb[j]; if (DUAL) acc2[i][j] += a[i] * b2[j]; }
        }
        __syncthreads();
    }
#pragma unroll
    for (int i = 0; i < 4; ++i)
#pragma unroll
        for (int j = 0; j < 4; ++j) ef(m0 + ty * 4 + i, n0 + tx * 4 + j, acc[i][j], acc2[i][j]);
}

__global__ __launch_bounds__(256) void k_gemm_in(P p, int l) {
    const float* W = p.w_in + (size_t)l * 1024 * INW;
    const float* A = p.Hb;
    float* Z = p.Zb;
    gemm_tile<false>(blockIdx.y * 64, blockIdx.x * 64, 1024,
                     [=](int m, int k) { return A[(size_t)m * 1024 + k]; },
                     [=](int k, int n, int) { return W[(size_t)k * INW + n]; },
                     [=](int m, int n, float a, float) { Z[(size_t)m * INW + n] = a; });
}

__global__ __launch_bounds__(256) void k_gemm_out(P p, int l) {
    const float* W = p.w_out + (size_t)l * 1024 * 1024;
    const float* A = p.MIX;
    float* X = p.X;
    const float* mv = p.modv + (size_t)(l * 5) * 6144;
    gemm_tile<false>(blockIdx.y * 64, blockIdx.x * 64, 1024,
                     [=](int m, int k) { return A[(size_t)m * 1024 + k]; },
                     [=](int k, int n, int) { return W[(size_t)k * 1024 + n]; },
                     [=](int m, int n, float a, float) {
                         const int s = mods_of_tok(m);
                         X[(size_t)m * 1024 + n] += mv[(size_t)s * 6144 + 2048 + n] * a;
                     });
}

__global__ __launch_bounds__(256) void k_moe_up(P p, int l) {
    const int m0 = blockIdx.y * 64;
    const int e = p.blkexp[m0 >> 8];
    if (e < 0) return;
    const float* Wg = p.wg + (size_t)(l * NE + e) * 1024 * FF;
    const float* Wu = p.wu + (size_t)(l * NE + e) * 1024 * FF;
    const float* H2 = p.H2;
    const int* rowtok = p.rowtok;
    float* ACT = p.ACT;
    gemm_tile<true>(m0, blockIdx.x * 64, 1024,
                    [=](int r, int k) { const int t = rowtok[r]; return t < 0 ? 0.f : H2[(size_t)t * 1024 + k]; },
                    [=](int k, int n, int w) { return (w ? Wu : Wg)[(size_t)k * FF + n]; },
                    [=](int r, int n, float g, float u) { ACT[(size_t)r * FF + n] = siluf(g) * u; });
}

__global__ __launch_bounds__(256) void k_moe_down(P p, int l) {
    const int m0 = blockIdx.y * 64;
    const int e = p.blkexp[m0 >> 8];
    if (e < 0) return;
    const float* Wd = p.wd + (size_t)(l * NE + e) * FF * 1024;
    const float* ACT = p.ACT;
    const int* rowtok = p.rowtok;
    const float* roww = p.roww;
    float* X = p.X;
    const float* mv = p.modv + (size_t)(l * 5) * 6144;
    gemm_tile<false>(m0, blockIdx.x * 64, FF,
                     [=](int r, int k) { return ACT[(size_t)r * FF + k]; },
                     [=](int k, int n, int) { return Wd[(size_t)k * 1024 + n]; },
                     [=](int r, int n, float a, float) {
                         const int t = rowtok[r];
                         if (t >= 0) {
                             const int s = mods_of_tok(t);
                             atomicAdd(&X[(size_t)t * 1024 + n], mv[(size_t)s * 6144 + 5120 + n] * roww[r] * a);
                         }
                     });
}

__global__ void k_prep(P p, int l) {
    const int wv = (blockIdx.x * blockDim.x + threadIdx.x) >> 6, lane = threadIdx.x & 63, nw = (gridDim.x * blockDim.x) >> 6;
    for (int it = wv; it < RB * 30; it += nw) {
        const int r = it / 30, u = it % 30;
        float* z = p.Zb + (size_t)r * INW;
        const bool lat = r < SEQ;
        int col, kind;
        if (u < 4) { kind = 0; col = u * 64; }
        else if (u < 8) { kind = 1; col = 256 + (u - 4) * 64; }
        else if (u < 12) { kind = 2; col = 1024 + (u - 8) * 64; }
        else if (u < 14) { kind = 3; col = 1280 + (u - 12) * 64; }
        else if (u < 18) { kind = 4; col = 1792 + (u - 14) * 64; }
        else if (u < 22) { kind = 5; col = 2048 + (u - 18) * 64; }
        else if (u < 26) { kind = 6; col = 2816 + (u - 22) * 64; }
        else { kind = 7; col = 3072 + (u - 26) * 64; }
        float v = z[col + lane];
        if (kind == 0) v *= 0.125f;
        if (kind == 2 || kind == 3) {
            const float ss = wave_sum(v * v);
            v = v * (1.0f / sqrtf(ss * (1.f / 64.f) + 1e-6f)) * (kind == 2 ? p.gq_g[l * 64 + lane] : p.gk_g[l * 64 + lane]);
        }
        if (kind == 4 || kind == 5) {
            const int dir = kind - 4, w = (col - (kind == 4 ? 1792 : 2048)) + lane;
            const float lb = p.lbv[(l * 2 + dir) * 256 + w];
            v = lb + (1.f - lb) * sigmf(v);
        }
        const int row = r >> 6, cl = r & 63;
        if (kind <= 3) {
            const int i = lane & 31, j = i & 15;
            const float pos = (i < 16) ? (float)row : (float)cl;
            const float ang = pos * powf(10000.f, -(float)j / 16.f);
            const float cs = cosf(ang), sn = sinf(ang);
            const float other = __shfl_xor(v, 32);
            if (lat) v = (lane < 32) ? v * cs - other * sn : v * cs + other * sn;
        }
        if (kind >= 6) {
            const int i = lane & 15, j = i & 7;
            const float pos = (i < 8) ? (float)row : (float)cl;
            const float ang = pos * powf(10000.f, -(float)j / 8.f);
            const float cs = cosf(ang), sn = sinf(ang);
            const float other = __shfl_xor(v, 16);
            if (lat) v = ((lane & 16) == 0) ? v * cs - other * sn : v * cs + other * sn;
        }
        z[col + lane] = v;
    }
}

__global__ __launch_bounds__(64) void k_recur(P p, int l) {
    const int id = blockIdx.x, mixer = id >> 3, h = (id >> 1) & 3, dir = id & 1, lane = threadIdx.x;
    int qc, kc, vc;
    if (mixer == 0) { qc = h * 64; kc = 256 + h * 64; vc = 512 + h * 64; }
    else { qc = 1536 + h * 64; kc = (dir == 0 ? 1792 : 2048) + h * 64; vc = 2304 + h * 64; }
    const float g = p.gam[(l * 2 + dir) * 4 + h];
    float S[64];
#pragma unroll
    for (int d = 0; d < 64; ++d) S[d] = 0.f;
    float* O = p.OFB + (size_t)(mixer * 2 + dir) * RB * 256 + h * 64;
    for (int step = 0; step < RB; ++step) {
        int r;
        if (dir == 0) r = step < CTX ? SEQ + step : step - CTX;
        else r = step < CTX ? SEQ + (CTX - 1 - step) : (SEQ - 1) - (step - CTX);
        const float* z = p.Zb + (size_t)r * INW;
        const float vv = z[vc + lane];
        float o = 0.f;
#pragma unroll
        for (int d = 0; d < 64; ++d) {
            const float kk = z[kc + d], qq = z[qc + d];
            const float a = (mixer == 0) ? g : kk;
            const float k_ = (mixer == 0) ? kk : 1.f - kk;
            S[d] = a * S[d] + k_ * vv;
            o += S[d] * qq;
        }
        O[(size_t)r * 256 + lane] = o;
    }
}

__global__ void k_readout(P p, int l, int b) {
    const int wv = (blockIdx.x * blockDim.x + threadIdx.x) >> 6, lane = threadIdx.x & 63, nw = (gridDim.x * blockDim.x) >> 6;
    for (int it = wv; it < RB * 8; it += nw) {
        const int r = it >> 3, mixer = (it >> 2) & 1, h = it & 3;
        const float o = p.OFB[((size_t)(mixer * 2 + 0) * RB + r) * 256 + h * 64 + lane] + p.OFB[((size_t)(mixer * 2 + 1) * RB + r) * 256 + h * 64 + lane];
        const float ss = wave_sum(o * o);
        const float ng = mixer == 0 ? p.ret_ng[l * 64 + lane] : p.hg_ng[l * 64 + lane];
        const float y = o * (1.0f / sqrtf(ss * (1.f / 64.f) + 1e-6f)) * ng;
        const float gate = p.Zb[(size_t)r * INW + (mixer == 0 ? 768 : 2560) + h * 64 + lane];
        p.MIX[(size_t)tok_of(b, r) * 1024 + (mixer == 0 ? 0 : 512) + h * 64 + lane] = y * siluf(gate);
    }
}

__global__ __launch_bounds__(256) void k_attn_gqa(P p, int l, int b, int need_ctx) {
    const int hq = blockIdx.y, kvh = hq >> 1, r = blockIdx.x * 256 + threadIdx.x;
    const bool isctx = r >= SEQ;
    if (isctx && !need_ctx) return;
    const float* zq = p.Zb + (size_t)r * INW + 1024 + hq * 64;
    float q[64], o[64];
#pragma unroll
    for (int d = 0; d < 64; ++d) { q[d] = zq[d]; o[d] = 0.f; }
    float m = -INFINITY, ls = 0.f;
    const int nk = isctx ? CTX : RB;
    for (int j = 0; j < nk; ++j) {
        const int kr = j < CTX ? SEQ + j : j - CTX;
        const float* zk = p.Zb + (size_t)kr * INW + 1280 + kvh * 64;
        const float* zv = zk + 128;
        float s = 0.f;
#pragma unroll
        for (int d = 0; d < 64; ++d) s += q[d] * zk[d];
        s *= 0.125f;
        const float mn = fmaxf(m, s), corr = expf(m - mn), pe = expf(s - mn);
        ls = ls * corr + pe;
#pragma unroll
        for (int d = 0; d < 64; ++d) o[d] = o[d] * corr + pe * zv[d];
        m = mn;
    }
    float* out = p.MIX + (size_t)tok_of(b, r) * 1024 + 256 + hq * 64;
    const float inv = 1.f / ls;
#pragma unroll
    for (int d = 0; d < 64; ++d) out[d] = o[d] * inv;
}

__global__ __launch_bounds__(256) void k_attn_diff(P p, int l, int b, int need_ctx) {
    const int h = blockIdx.y, r = blockIdx.x * 256 + threadIdx.x;
    const bool isctx = r >= SEQ;
    if (isctx && !need_ctx) return;
    const float* zq = p.Zb + (size_t)r * INW + 2816 + h * 64;
    float q[64], o1[64], o2[64];
#pragma unroll
    for (int d = 0; d < 64; ++d) { q[d] = zq[d]; o1[d] = 0.f; o2[d] = 0.f; }
    float m1 = -INFINITY, l1 = 0.f, m2 = -INFINITY, l2 = 0.f;
    const int nk = isctx ? CTX : RB;
    const float sc = 0.17677669529663687f;
    for (int j = 0; j < nk; ++j) {
        const int kr = j < CTX ? SEQ + j : j - CTX;
        const float* zk = p.Zb + (size_t)kr * INW + 3072 + h * 64;
        const float* zv = zk + 256;
        float s1 = 0.f, s2 = 0.f;
#pragma unroll
        for (int d = 0; d < 32; ++d) { s1 += q[d] * zk[d]; s2 += q[32 + d] * zk[32 + d]; }
        s1 *= sc; s2 *= sc;
        const float mn1 = fmaxf(m1, s1), c1 = expf(m1 - mn1), p1 = expf(s1 - mn1);
        const float mn2 = fmaxf(m2, s2), c2 = expf(m2 - mn2), p2 = expf(s2 - mn2);
        l1 = l1 * c1 + p1; l2 = l2 * c2 + p2;
#pragma unroll
        for (int d = 0; d < 64; ++d) { const float vv = zv[d]; o1[d] = o1[d] * c1 + p1 * vv; o2[d] = o2[d] * c2 + p2 * vv; }
        m1 = mn1; m2 = mn2;
    }
    const float lam = p.lam[l * 2], li = p.lam[l * 2 + 1];
    const float i1 = 1.f / l1, i2 = lam / l2;
    float ss = 0.f;
#pragma unroll
    for (int d = 0; d < 64; ++d) { o1[d] = o1[d] * i1 - o2[d] * i2; ss += o1[d] * o1[d]; }
    const float rstd = 1.0f / sqrtf(ss * (1.f / 64.f) + 1e-6f);
    float* out = p.MIX + (size_t)tok_of(b, r) * 1024 + 768 + h * 64;
#pragma unroll
    for (int d = 0; d < 64; ++d) out[d] = o1[d] * rstd * p.df_ng[l * 64 + d] * (1.f - li);
}

__global__ void k_norm2_route(P p, int l, int nrows) {
    const int wv = (blockIdx.x * blockDim.x + threadIdx.x) >> 6, lane = threadIdx.x & 63, nw = (gridDim.x * blockDim.x) >> 6;
    for (int m = wv; m < nrows; m += nw) {
        const int s = mods_of_tok(m);
        const float* xr = p.X + (size_t)m * 1024;
        float v[16], ss = 0.f;
#pragma unroll
        for (int j = 0; j < 16; ++j) { v[j] = xr[lane + 64 * j]; ss += v[j] * v[j]; }
        ss = wave_sum(ss);
        const float rstd = 1.0f / sqrtf(ss * (1.f / 1024.f) + 1e-6f);
        const float* mv = p.modv + (size_t)(l * 5 + s) * 6144;
        float lg[NE];
#pragma unroll
        for (int e = 0; e < NE; ++e) lg[e] = 0.f;
#pragma unroll
        for (int j = 0; j < 16; ++j) {
            const int k = lane + 64 * j;
            const float hv = v[j] * rstd * p.n2g[l * 1024 + k] * (1.f + mv[4096 + k]) + mv[3072 + k];
            p.H2[(size_t)m * 1024 + k] = hv;
            const float* rw = p.r_w + (size_t)k * NE;
#pragma unroll
            for (int e = 0; e < NE; ++e) lg[e] += hv * rw[e];
        }
#pragma unroll
        for (int e = 0; e < NE; ++e) lg[e] = wave_sum(lg[e]);
        float my = 0.f;
#pragma unroll
        for (int e = 0; e < NE; ++e) my = ((lane & 31) == e) ? lg[e] : my;
        const float sc = sigmf(my), sel = sc + p.r_b[lane & 31];
        const int gb = lane & 28;
        const float v0 = __shfl(sel, gb), v1 = __shfl(sel, gb + 1), v2 = __shfl(sel, gb + 2), v3 = __shfl(sel, gb + 3);
        float ta = v0, tb = -INFINITY;
#define TOP2(t) { if ((t) > ta) { tb = ta; ta = (t); } else if ((t) > tb) tb = (t); }
        TOP2(v1) TOP2(v2) TOP2(v3)
        const float gs = ta + tb;
        int bg = 0; float bgs = __shfl(gs, 0);
#pragma unroll
        for (int g = 1; g < 8; ++g) { const float t = __shfl(gs, g * 4); if (t > bgs) { bgs = t; bg = g; } }
        const float s0 = __shfl(sel, bg * 4), s1 = __shfl(sel, bg * 4 + 1), s2 = __shfl(sel, bg * 4 + 2), s3 = __shfl(sel, bg * 4 + 3);
        const float c0 = __shfl(sc, bg * 4), c1 = __shfl(sc, bg * 4 + 1), c2 = __shfl(sc, bg * 4 + 2), c3 = __shfl(sc, bg * 4 + 3);
        int i0 = 0, i1 = -1; float fa = s0, fb = -INFINITY;
#define TOP2I(t, i) { if ((t) > fa) { fb = fa; i1 = i0; fa = (t); i0 = (i); } else if ((t) > fb) { fb = (t); i1 = (i); } }
        TOP2I(s1, 1) TOP2I(s2, 2) TOP2I(s3, 3)
        const float g0 = i0 == 0 ? c0 : i0 == 1 ? c1 : i0 == 2 ? c2 : c3;
        const float g1 = i1 == 0 ? c0 : i1 == 1 ? c1 : i1 == 2 ? c2 : c3;
        if (lane == 0) {
            const int e0 = bg * 4 + i0, e1 = bg * 4 + i1;
            const float inv = 1.f / (g0 + g1);
            p.eid[m * 2] = e0; p.eid[m * 2 + 1] = e1;
            p.gw[m * 2] = g0 * inv; p.gw[m * 2 + 1] = g1 * inv;
            atomicAdd(&p.cnt[l * NE + e0], 1);
            atomicAdd(&p.cnt[l * NE + e1], 1);
        }
    }
}

__global__ void k_moe_offsets(P p, int l) {
    if (blockIdx.x == 0 && threadIdx.x == 0) {
        int acc = 0;
        for (int e = 0; e < NE; ++e) {
            p.pstart[l * NE + e] = acc;
            const int nb = (p.cnt[l * NE + e] + 255) >> 8;
            for (int j = 0; j < nb; ++j) p.blkexp[(acc >> 8) + j] = e;
            acc += nb << 8;
        }
        for (int j = acc >> 8; j < RMAX / 256; ++j) p.blkexp[j] = -1;
    }
}

__global__ void k_moe_scatter(P p, int l, int nrows) {
    const int gid = blockIdx.x * blockDim.x + threadIdx.x;
    if (gid < nrows * 2) {
        const int e = p.eid[gid];
        const int r = p.pstart[l * NE + e] + atomicAdd(&p.fill[l * NE + e], 1);
        p.rowtok[r] = gid >> 1;
        p.roww[r] = p.gw[gid];
    }
}

__global__ void k_final(P p) {
    const int wv = (blockIdx.x * blockDim.x + threadIdx.x) >> 6, lane = threadIdx.x & 63, nw = (gridDim.x * blockDim.x) >> 6;
    for (int m = wv; m < NLAT; m += nw) {
        const float* xr = p.X + (size_t)m * 1024;
        float v[16], ss = 0.f;
#pragma unroll
        for (int j = 0; j < 16; ++j) { v[j] = xr[lane + 64 * j]; ss += v[j] * v[j]; }
        ss = wave_sum(ss);
        const float rstd = 1.0f / sqrtf(ss * (1.f / 1024.f) + 1e-6f);
#pragma unroll
        for (int j = 0; j < 16; ++j) { const int k = lane + 64 * j; p.out[(size_t)m * 1024 + k] = v[j] * rstd * p.fin_g[k]; }
    }
}

extern "C" void kernel_launch(void* const* d_in, const int* in_sizes, int n_in, void* d_out, int out_size, void* d_ws, size_t ws_size,
                              hipStream_t stream) {
    P p{};
    const float** ins = (const float**)&p;
    for (int i = 0; i < 24; ++i) ins[i] = (const float*)d_in[i];
    p.out = (float*)d_out;
    char* ws = (char*)d_ws;
    size_t off = 0;
    auto take = [&](size_t bytes) { void* r = ws + off; off += (bytes + 255) & ~(size_t)255; return r; };
    int* ctl = (int*)take(4096);
    p.cnt = ctl; p.fill = ctl + 64; p.pstart = ctl + 128;
    p.blkexp = (int*)take(4096);
    p.modv = (float*)take(2 * 5 * 6144 * 4);
    p.lbv = (float*)take(1024 * 4);
    p.gam = (float*)take(64);
    p.lam = (float*)take(64);
    p.rowtok = (int*)take((size_t)RMAX * 4);
    p.roww = (float*)take((size_t)RMAX * 4);
    p.eid = (int*)take((size_t)NTOK * 2 * 4);
    p.gw = (float*)take((size_t)NTOK * 2 * 4);
    p.X = (float*)take((size_t)NTOK * 1024 * 4);
    const size_t regB = off;
    p.Hb = (float*)take((size_t)RB * 1024 * 4);
    p.Zb = (float*)take((size_t)RB * INW * 4);
    p.OFB = (float*)take((size_t)4 * RB * 256 * 4);
    p.MIX = (float*)take((size_t)NTOK * 1024 * 4);
    off = regB;
    p.H2 = (float*)take((size_t)NTOK * 1024 * 4);
    p.ACT = (float*)take((size_t)RMAX * FF * 4);

    (void)hipMemsetAsync(ctl, 0, 4096, stream);
    (void)hipMemcpyAsync(p.X, d_in[0], (size_t)NLAT * 1024 * 4, hipMemcpyDeviceToDevice, stream);
    (void)hipMemcpyAsync(p.X + (size_t)NLAT * 1024, d_in[2], (size_t)NCTX * 1024 * 4, hipMemcpyDeviceToDevice, stream);
    k_setup<<<48, 256, 0, stream>>>(p);
    for (int l = 0; l < 2; ++l) {
        const int need_ctx = (l == 0);
        const int nrows = need_ctx ? NTOK : NLAT;
        for (int b = 0; b < NB; ++b) {
            k_rowprep<<<1056, 256, 0, stream>>>(p, l, b);
            k_gemm_in<<<dim3(INW / 64, RB / 64), 256, 0, stream>>>(p, l);
            k_prep<<<2048, 256, 0, stream>>>(p, l);
            k_recur<<<16, 64, 0, stream>>>(p, l);
            k_attn_gqa<<<dim3(RB / 256, 4), 256, 0, stream>>>(p, l, b, need_ctx);
            k_attn_diff<<<dim3(RB / 256, 4), 256, 0, stream>>>(p, l, b, need_ctx);
            k_readout<<<1056, 256, 0, stream>>>(p, l, b);
        }
        k_gemm_out<<<dim3(1024 / 64, nrows / 64), 256, 0, stream>>>(p, l);
        (void)hipMemsetAsync(p.rowtok, 0xFF, (size_t)RMAX * 4, stream);
        k_norm2_route<<<2048, 256, 0, stream>>>(p, l, nrows);
        k_moe_offsets<<<1, 64, 0, stream>>>(p, l);
        k_moe_scatter<<<(nrows * 2 + 255) / 256, 256, 0, stream>>>(p, l, nrows);
        k_moe_up<<<dim3(FF / 64, RMAX / 64), 256, 0, stream>>>(p, l);
        k_moe_down<<<dim3(1024 / 64, RMAX / 64), 256, 0, stream>>>(p, l);
    }
    k_final<<<2048, 256, 0, stream>>>(p);
}
```

```cpp
#include <hip/hip_runtime.h>
#include <cstdio>
#include <cstdint>
#include <math.h>

#define DM 1024
#define NB 4
#define SEQ 8192
#define CTX 256
#define NLAT (NB * SEQ)
#define NCTX (NB * CTX)
#define NTOK (NLAT + NCTX)
#define RB (SEQ + CTX)
#define INW 3584
#define NE 32
#define FF 512
#define RMAX 75776
__device__ __forceinline__ int phase_tid_(int wave_sg) { int w = wave_sg; asm volatile("" : "+s"(w));
    int t = (w << 6) | (int)__builtin_amdgcn_mbcnt_hi(~0u, __builtin_amdgcn_mbcnt_lo(~0u, 0u)); asm volatile("" : "+v"(t)); return t; }
#define phase_tid() phase_tid_(wave_sg)
namespace pg8 {
#define PG8_LAS __attribute__((address_space(3)))
typedef unsigned short bf16_t;
typedef short bf16x8 __attribute__((ext_vector_type(8)));
typedef float f32x4 __attribute__((ext_vector_type(4)));
typedef unsigned u32x4 __attribute__((ext_vector_type(4)));
constexpr int BM = 256, BK = 64, HALF = 128, HTB = HALF * BK * 2  , STAGE_BYTES = 8 * HTB, NXCD = 8, WGM = 8;

__host__ __device__ __forceinline__ int lds_byte(int r, int c) { const int st = (r >> 4) * 2 + (c >> 5), rr = r & 15, cc = c & 31, ob = rr * 64 + cc * 2; return st * 1024 + (ob ^ (((ob >> 9) & 1) << 5)); }
__host__ __device__ __forceinline__ void stage_rc(int b, int& R, int& C) { const int st = b / 1024, sb = b % 1024, swz = sb ^ (((sb >> 9) & 1) << 5); R = (st >> 1) * 16 + swz / 64; C = (st & 1) * 32 + (swz % 64) / 2; }
__host__ __device__ __forceinline__ int perm32(int rho) { const int n = rho >> 4, i = rho & 15; return 8 * (i >> 2) + 4 * n + (i & 3); }

struct Unit { int pm, pn; };
struct Gemm { const bf16_t* A; const bf16_t* Bt; int M, N, K; };

struct StaticOrder {
    int nM, nN, nwg, G, c;
    __host__ __device__ void init(int M, int N, int G_, int c_) { nM = M / BM; nN = N / BM; nwg = nM * nN; G = G_; c = c_; }
    __host__ __device__ bool next(int i, Unit& u) const {
        const long L = (long)i * G + c; if (L >= nwg) return false;
        int wgid = (int)L; { const int q = nwg / NXCD, r = nwg % NXCD, xcd = wgid % NXCD, off = wgid / NXCD; wgid = (xcd < r ? xcd * (q + 1) : r * (q + 1) + (xcd - r) * q) + off; }
        const int nig = WGM * nN, gid = wgid / nig, fm = gid * WGM, gsz = (nM - fm) < WGM ? (nM - fm) : WGM;
        u.pm = fm + ((wgid % nig) % gsz); u.pn = (wgid % nig) / gsz; return true;
    }
    __device__ __forceinline__ void a_ready(const Unit&) const {}
    __device__ __forceinline__ void done(const Unit&) const {}
};

__device__ __forceinline__ unsigned cvt_pk_bf16(float lo, float hi) { unsigned r; asm volatile("v_cvt_pk_bf16_f32 %0, %1, %2" : "=v"(r) : "v"(lo), "v"(hi)); return r; }
typedef float f32x2 __attribute__((ext_vector_type(2)));
__device__ __forceinline__ f32x2 gelu_pk(f32x2 v) {
    const f32x2 av = __builtin_elementwise_abs(v), d = av * 0.2316418882f + 1.0f;
    f32x2 t; t.x = __builtin_amdgcn_rcpf(d.x); t.y = __builtin_amdgcn_rcpf(d.y);
    f32x2 q = t * 0.5307027145f + (-0.7265760135f); q = q * t + 0.7107068705f; q = q * t + (-0.142248368f); q = q * t + 0.127414796f; q = q * t;
    const f32x2 s = (v * v) * (-0.72134752044f);
    f32x2 e; e.x = __builtin_amdgcn_exp2f(s.x); e.y = __builtin_amdgcn_exp2f(s.y);
    const f32x2 m = v * (q * e), r = v - m;
    f32x2 o; o.x = v.x < 0.f ? m.x : r.x; o.y = v.y < 0.f ? m.y : r.y; return o;
}

template <int ACT  > struct EpiBf16 {
    static constexpr bool PERM = true, AFTER_DRAIN = false; static_assert(ACT == 0 || ACT == 1, "EpiBf16: ACT is 0 (none) or 1 (gelu_pk)");
    bf16_t* O; int ldc; const float* bias; int split_cols; size_t split_stride; float scale0;
    __device__ __forceinline__ void operator()(const f32x4 (&acc)[2][2][4][2], const Unit& u, int wr, int wc, int fr, int fq) const {
        const int row0 = u.pm * BM + wr * 64 + fr; int colt = u.pn * BM; bf16_t* base = O;
        float sc = 1.f; if (split_cols) { const int t = colt / split_cols; base += (size_t)t * split_stride; colt -= t * split_cols; if (t == 0) sc = scale0; }
        const int col0 = colt + wc * 32 + 8 * fq, bcol0 = u.pn * BM + wc * 32 + 8 * fq;
        f32x4 bv[2][2];
#pragma unroll
        for (int bj = 0; bj < 2; ++bj)
#pragma unroll
            for (int n = 0; n < 2; ++n) bv[bj][n] = bias ? *(const f32x4*)(bias + bcol0 + bj * HALF + 4 * n) : (f32x4){0.f, 0.f, 0.f, 0.f};
#pragma unroll
        for (int ai = 0; ai < 2; ++ai)
#pragma unroll
            for (int m = 0; m < 4; ++m) { bf16_t* rowp = base + (size_t)(row0 + ai * HALF + m * 16) * ldc + col0;
#pragma unroll
                for (int bj = 0; bj < 2; ++bj) { f32x4 v0 = acc[ai][bj][m][0] + bv[bj][0], v1 = acc[ai][bj][m][1] + bv[bj][1];
                    if (ACT == 1) { f32x2 a = gelu_pk((f32x2){v0[0], v0[1]}), b = gelu_pk((f32x2){v0[2], v0[3]}), c = gelu_pk((f32x2){v1[0], v1[1]}), d = gelu_pk((f32x2){v1[2], v1[3]});
                        v0 = (f32x4){a.x, a.y, b.x, b.y}; v1 = (f32x4){c.x, c.y, d.x, d.y}; }
                    v0 = v0 * sc; v1 = v1 * sc; u32x4 w; w.x = cvt_pk_bf16(v0[0], v0[1]); w.y = cvt_pk_bf16(v0[2], v0[3]); w.z = cvt_pk_bf16(v1[0], v1[1]); w.w = cvt_pk_bf16(v1[2], v1[3]);
                    *(__attribute__((address_space(1))) u32x4*)(rowp + bj * HALF) = w; } }
    }
};

template <class Epi, class Sched, bool ALIGN_EPI = false, bool SP2 = false, bool GATHER = false>
__device__ __forceinline__ void gemm_phase(PG8_LAS unsigned char* lds, const Gemm g, const Sched& S, const Epi& E, int wave_sg) {
    const int tid = phase_tid(), wid = __builtin_amdgcn_readfirstlane(tid >> 6), lane = tid & 63, wr = wid >> 2, wc = wid & 3, fr = lane & 15, fq = lane >> 4;
    const int K = g.K, nt = K / BK;
    unsigned voffA[2], voffB[2];
#pragma unroll
    for (int i = 0; i < 2; ++i) { int R, C; stage_rc(tid * 16 + i * 8192, R, C); const int Rb = Epi::PERM ? ((R & ~31) + perm32(R & 31)) : R;
        voffA[i] = (unsigned)(R * K + C) * 2u; voffB[i] = (unsigned)(Rb * K + C) * 2u; }
    const size_t kstep = (size_t)(BK * 2);
    const size_t hstep = (size_t)HALF * K * 2;
    const size_t tstep = 2 * hstep;
    const unsigned ldsw = (unsigned)wid * 1024u;
    const int aoff = lds_byte(wr * 64 + fr, fq * 8), boff = lds_byte(wc * 32 + fr, fq * 8);
#define PG8_SA(b, h) (((b) * 2 + (h)) * HTB)
#define PG8_SB(b, h) ((4 + (b) * 2 + (h)) * HTB)
#define PG8_STAGE(bufoff, gbase, voff) do { _Pragma("unroll") for (int _i = 0; _i < 2; ++_i) \
        __builtin_amdgcn_global_load_lds((const unsigned*)((const char*)(gbase) + (voff)[_i]), (PG8_LAS unsigned*)(lds + (bufoff) + ldsw + _i * 8192), 16, 0, 0); } while (0)
#define PG8_STAGE_A(bufoff, aptr, kb, h, nx) do { if constexpr (GATHER) { _Pragma("unroll") for (int _i = 0; _i < 2; ++_i) \
        __builtin_amdgcn_global_load_lds((const unsigned*)(gA0 + (kb) + gC[h][_i]), (PG8_LAS unsigned*)(lds + (bufoff) + ldsw + _i * 8192), 16, 0, 0); } \
    else { PG8_STAGE(bufoff, (aptr) + ((h) ? hstep : 0), voffA); } } while (0)
#define PG8_GOFF(dst, unit) do { _Pragma("unroll") for (int _h = 0; _h < 2; ++_h) _Pragma("unroll") for (int _i = 0; _i < 2; ++_i) { int R_, C_; stage_rc(tid * 16 + _i * 8192, R_, C_); \
        dst[_h][_i] = (unsigned)(((size_t)S.arow(unit, _h * HALF + R_) * K + C_) * 2u); } } while (0)
#define PG8_LDA(dst, b, h) do { _Pragma("unroll") for (int m = 0; m < 4; ++m) _Pragma("unroll") for (int k = 0; k < 2; ++k) dst[m][k] = *(const PG8_LAS bf16x8*)(lds + PG8_SA(b, h) + aoff + m * 2048 + k * 1024); } while (0)
#define PG8_LDB(dst, b, h) do { _Pragma("unroll") for (int n = 0; n < 2; ++n) _Pragma("unroll") for (int k = 0; k < 2; ++k) dst[n][k] = *(const PG8_LAS bf16x8*)(lds + PG8_SB(b, h) + boff + n * 2048 + k * 1024); } while (0)
#define PG8_MMA(ai, bj, At, Bt) do { __builtin_amdgcn_s_setprio(1); _Pragma("unroll") for (int m = 0; m < 4; ++m) _Pragma("unroll") for (int n = 0; n < 2; ++n) _Pragma("unroll") for (int k = 0; k < 2; ++k) \
        acc[ai][bj][m][n] = __builtin_amdgcn_mfma_f32_16x16x32_bf16(Bt[n][k], At[m][k], acc[ai][bj][m][n], 0, 0, 0); __builtin_amdgcn_s_setprio(0); } while (0)
#define PG8_WAIT_V(n) asm volatile("s_waitcnt vmcnt(" #n ")" ::: "memory")
#define PG8_WAIT_L(n) asm volatile("s_waitcnt lgkmcnt(" #n ")" ::: "memory")
#define PG8_BAR __builtin_amdgcn_s_barrier()
#define PG8_SCHED __builtin_amdgcn_sched_barrier(0)
    Unit cur, nxt; int ui = 0;
    if (!S.next(0, cur)) return;
    const char* gA0 = (const char*)g.A; unsigned gC[2][2] = {{0u, 0u}, {0u, 0u}};
    PG8_LAS u32x4* gNs = (PG8_LAS u32x4*)(lds + 131072 + 4096) + tid;
    if constexpr (GATHER) PG8_GOFF(gC, cur);
    f32x4 acc[2][2][4][2];
#pragma unroll
    for (int a = 0; a < 2; ++a)
#pragma unroll
        for (int b = 0; b < 2; ++b)
#pragma unroll
            for (int m = 0; m < 4; ++m)
#pragma unroll
                for (int n = 0; n < 2; ++n) acc[a][b][m][n] = (f32x4){0.f, 0.f, 0.f, 0.f};
    bf16x8 At[4][2], B0[2][2], B1[2][2];
    const char* cA = (const char*)g.A + (size_t)cur.pm * tstep; const char* cB = (const char*)g.Bt + (size_t)cur.pn * tstep;
    S.a_ready(cur);
    if constexpr (SP2) {
        PG8_STAGE(PG8_SB(0, 0), cB, voffB); PG8_STAGE(PG8_SB(0, 1), cB + hstep, voffB); PG8_STAGE_A(PG8_SA(0, 0), cA, 0, 0, false); PG8_STAGE_A(PG8_SA(0, 1), cA, 0, 1, false);
        if (wr == 1) PG8_BAR;
        PG8_WAIT_V(2); PG8_BAR;
        PG8_STAGE(PG8_SB(1, 0), cB + kstep, voffB); PG8_STAGE_A(PG8_SA(1, 0), cA + kstep, kstep, 0, false); PG8_STAGE(PG8_SB(1, 1), cB + hstep + kstep, voffB);
        PG8_WAIT_V(6); PG8_BAR;
    } else {
        PG8_STAGE(PG8_SB(0, 0), cB, voffB); PG8_STAGE_A(PG8_SA(0, 0), cA, 0, 0, false); PG8_STAGE(PG8_SB(0, 1), cB + hstep, voffB); PG8_STAGE_A(PG8_SA(0, 1), cA, 0, 1, false);
        if (wr == 1) PG8_BAR;
        PG8_WAIT_V(4); PG8_BAR;
        PG8_STAGE(PG8_SB(1, 0), cB + kstep, voffB); PG8_STAGE_A(PG8_SA(1, 0), cA + kstep, kstep, 0, false); PG8_STAGE(PG8_SB(1, 1), cB + hstep + kstep, voffB);
        PG8_WAIT_V(6); PG8_BAR;
    }
    for (;;) {
        const bool has_next = S.next(ui + 1, nxt);
        if constexpr (GATHER) { if (has_next) { unsigned gT[2][2]; PG8_GOFF(gT, nxt); *gNs = (u32x4){gT[0][0], gT[0][1], gT[1][0], gT[1][1]}; } }
        const char* nA = has_next ? (const char*)g.A + (size_t)nxt.pm * tstep : cA; const char* nB = has_next ? (const char*)g.Bt + (size_t)nxt.pn * tstep : cB;
        for (int t = 0; t < nt; t += 2) {
            const bool last = (t == nt - 2);
            const char* a1 = cA + (size_t)(t + 1) * kstep;
            const char* a2 = last ? nA : cA + (size_t)(t + 2) * kstep; const char* b2 = last ? nB : cB + (size_t)(t + 2) * kstep;
            const char* a3 = a2 + kstep; const char* b3 = b2 + kstep;
            const size_t k2 = last ? 0 : (size_t)(t + 2) * kstep; const bool nxu = last && has_next;
            if (last && has_next) S.a_ready(nxt);
            if constexpr (SP2) {
            PG8_LDB(B0, 0, 0); PG8_LDB(B1, 0, 1); PG8_SCHED; PG8_LDA(At, 0, 0); PG8_STAGE_A(PG8_SA(1, 1), a1, (size_t)(t + 1) * kstep, 1, false); if constexpr (GATHER) { if (nxu) { const u32x4 gx_ = *gNs; gC[0][0] = gx_.x; gC[0][1] = gx_.y; gC[1][0] = gx_.z; gC[1][1] = gx_.w; } }
            PG8_WAIT_V(8); PG8_WAIT_L(0); PG8_BAR; PG8_MMA(0, 0, At, B0); PG8_MMA(0, 1, At, B1); PG8_BAR; PG8_SCHED;
            PG8_LDA(At, 0, 1); PG8_STAGE(PG8_SB(0, 0), b2, voffB); PG8_STAGE(PG8_SB(0, 1), b2 + hstep, voffB); PG8_STAGE_A(PG8_SA(0, 0), a2, k2, 0, nxu);
            PG8_WAIT_V(8); PG8_WAIT_L(0); PG8_BAR; PG8_MMA(1, 0, At, B0); PG8_MMA(1, 1, At, B1); PG8_BAR; PG8_SCHED;
            PG8_LDB(B0, 1, 0); PG8_LDB(B1, 1, 1); PG8_SCHED; PG8_LDA(At, 1, 0); PG8_STAGE_A(PG8_SA(0, 1), a2, k2, 1, nxu);
            PG8_WAIT_V(8); PG8_WAIT_L(0); PG8_BAR; PG8_MMA(0, 0, At, B0); PG8_MMA(0, 1, At, B1); PG8_BAR; PG8_SCHED;
            PG8_LDA(At, 1, 1); PG8_STAGE(PG8_SB(1, 0), b3, voffB); PG8_STAGE(PG8_SB(1, 1), b3 + hstep, voffB); PG8_STAGE_A(PG8_SA(1, 0), a3, k2 + kstep, 0, nxu);
            PG8_WAIT_V(8); PG8_WAIT_L(0); PG8_BAR; PG8_MMA(1, 0, At, B0); PG8_MMA(1, 1, At, B1); PG8_BAR; PG8_SCHED;
            } else {
            PG8_LDB(B0, 0, 0); PG8_SCHED; PG8_LDA(At, 0, 0); PG8_STAGE_A(PG8_SA(1, 1), a1, (size_t)(t + 1) * kstep, 1, false); if constexpr (GATHER) { if (nxu) { const u32x4 gx_ = *gNs; gC[0][0] = gx_.x; gC[0][1] = gx_.y; gC[1][0] = gx_.z; gC[1][1] = gx_.w; } }
            PG8_WAIT_L(8); PG8_BAR; PG8_WAIT_L(0); PG8_MMA(0, 0, At, B0); PG8_BAR; PG8_SCHED;
            PG8_LDB(B1, 0, 1); PG8_STAGE(PG8_SB(0, 0), b2, voffB);
            PG8_BAR; PG8_WAIT_L(0); PG8_MMA(0, 1, At, B1); PG8_BAR;
            PG8_LDA(At, 0, 1); PG8_STAGE_A(PG8_SA(0, 0), a2, k2, 0, nxu);
            PG8_BAR; PG8_WAIT_L(0); PG8_MMA(1, 0, At, B0); PG8_BAR; PG8_SCHED;
            PG8_STAGE(PG8_SB(0, 1), b2 + hstep, voffB);
            PG8_WAIT_V(6); PG8_BAR; PG8_MMA(1, 1, At, B1); PG8_BAR;
            PG8_LDB(B0, 1, 0); PG8_SCHED; PG8_LDA(At, 1, 0); PG8_STAGE_A(PG8_SA(0, 1), a2, k2, 1, nxu);
            PG8_WAIT_L(8); PG8_BAR; PG8_WAIT_L(0); PG8_MMA(0, 0, At, B0); PG8_BAR; PG8_SCHED;
            PG8_LDB(B1, 1, 1); PG8_STAGE(PG8_SB(1, 0), b3, voffB);
            PG8_BAR; PG8_WAIT_L(0); PG8_MMA(0, 1, At, B1); PG8_BAR;
            PG8_LDA(At, 1, 1); PG8_STAGE_A(PG8_SA(1, 0), a3, k2 + kstep, 0, nxu);
            PG8_BAR; PG8_WAIT_L(0); PG8_MMA(1, 0, At, B0); PG8_BAR; PG8_SCHED;
            PG8_STAGE(PG8_SB(1, 1), b3 + hstep, voffB);
            PG8_WAIT_V(6); PG8_BAR; PG8_MMA(1, 1, At, B1); PG8_BAR;
            }
        }
        if constexpr (ALIGN_EPI) { if (wr == 0) PG8_BAR; }
        if constexpr (!Epi::AFTER_DRAIN) { E(acc, cur, wr, wc, fr, fq); S.done(cur); }
        if (!has_next) break;
#pragma unroll
        for (int a = 0; a < 2; ++a)
#pragma unroll
            for (int b = 0; b < 2; ++b)
#pragma unroll
                for (int m = 0; m < 4; ++m)
#pragma unroll
                    for (int n = 0; n < 2; ++n) acc[a][b][m][n] = (f32x4){0.f, 0.f, 0.f, 0.f};
        cur = nxt; cA = nA; cB = nB; ++ui;
        if constexpr (ALIGN_EPI) { if (wr == 1) PG8_BAR; }
    }
    PG8_WAIT_V(0);
    if constexpr (!ALIGN_EPI) { if (wr == 0) PG8_BAR; }
    PG8_BAR;
    if constexpr (Epi::AFTER_DRAIN) { E.fused(acc, cur, wr, wc, fr, fq, lds, wid, lane); S.done(cur); }
#undef PG8_SA
#undef PG8_SB
#undef PG8_STAGE
#undef PG8_STAGE_A
#undef PG8_GOFF
#undef PG8_LDA
#undef PG8_LDB
#undef PG8_MMA
#undef PG8_WAIT_V
#undef PG8_WAIT_L
#undef PG8_BAR
#undef PG8_SCHED
}
}
#define GAS __attribute__((address_space(1)))
#define LAS __attribute__((address_space(3)))
typedef unsigned short bf16;
typedef unsigned v4u __attribute__((ext_vector_type(4)));
typedef float f32x4 __attribute__((ext_vector_type(4)));
typedef short bf16x8 __attribute__((ext_vector_type(8)));
typedef GAS unsigned gu32;
typedef GAS unsigned long long gu64;
#define RLX_AGENT __ATOMIC_RELAXED, __HIP_MEMORY_SCOPE_AGENT
#define LDS_WAIT() asm volatile("s_waitcnt lgkmcnt(0)" ::: "memory")
#define VM_WAIT() asm volatile("s_waitcnt vmcnt(0)" ::: "memory")
__device__ __forceinline__ unsigned long long rt() { return __builtin_amdgcn_s_memrealtime(); }
__device__ __forceinline__ unsigned f2bf(float f) { unsigned u = __builtin_bit_cast(unsigned, f); return (u + 0x7fffu + ((u >> 16) & 1u)) >> 16; }
__device__ __forceinline__ unsigned pk2(float lo, float hi) { return f2bf(lo) | (f2bf(hi) << 16); }

#define XB_TMO      128
#define XB_XCNT(j)  (256  + 64 * (j))
#define XB_XSUB(j)  (1280 + 64 * (j))
#define XB_XGEN(j)  (2304 + 64 * (j))
#define XB_TOP      3328
#define XB_TOPGEN   3392
#define XCD_BAR_WORDS 3456
#define XB_SPIN_CAP (1u << 18)

__device__ __forceinline__ unsigned xb_ld(unsigned* p)              { return __hip_atomic_load(p, __ATOMIC_RELAXED, __HIP_MEMORY_SCOPE_AGENT); }
__device__ __forceinline__ unsigned xb_add(unsigned* p, unsigned v) { return __hip_atomic_fetch_add(p, v, __ATOMIC_RELAXED, __HIP_MEMORY_SCOPE_AGENT); }
__device__ __forceinline__ unsigned xb_xcc_id() { return (unsigned)__builtin_amdgcn_s_getreg((3 << 11) | 20) & 0xFu; }
#define XB_SPIN(cond, bar) do { unsigned _sp = 0; while (cond) { __builtin_amdgcn_s_sleep(1); \
    if ((++_sp & 255u) == 0u) { if (xb_ld(&(bar)[XB_TMO])) break; if (_sp > XB_SPIN_CAP) { atomicAdd(&(bar)[XB_TMO], 1u); break; } } } } while (0)

struct XcdBarrier {
    unsigned* bar; unsigned x;
    volatile LAS unsigned* st;
};

__device__ __forceinline__ XcdBarrier xcd_barrier_post(unsigned* bar, volatile LAS unsigned* st) {
    XcdBarrier b; b.bar = bar; b.x = xb_xcc_id(); b.st = st;
    if (threadIdx.x == 0) (void)xb_add(&bar[XB_XCNT(b.x)], 1u);
    return b;
}
__device__ __forceinline__ void xcd_barrier_complete(unsigned* bar, unsigned x, unsigned& nloc, unsigned& nx) {
    const unsigned G = gridDim.x * gridDim.y * gridDim.z;
    unsigned sum, cnt, mine, sp = 0u;
    for (;;) {
        sum = 0u; cnt = 0u; mine = 0u;
#pragma unroll
        for (unsigned j = 0; j < 16; ++j) { const unsigned c = xb_ld(&bar[XB_XCNT(j)]); sum += c; cnt += (c > 0u) ? 1u : 0u; mine = (j == x) ? c : mine; }
        if (sum == G) break;
        __builtin_amdgcn_s_sleep(1);
        if ((++sp & 255u) == 0u) { if (xb_ld(&bar[XB_TMO])) break; if (sp > XB_SPIN_CAP) { atomicAdd(&bar[XB_TMO], 1u); break; } }
    }
    nloc = mine > 0u ? mine : 1u; nx = cnt > 0u ? cnt : 1u;
}

__device__ __forceinline__ void xcd_barrier(const XcdBarrier& b, int wave_sg  ) {
    asm volatile("s_waitcnt vmcnt(0)" ::: "memory");
    __syncthreads();
    if (wave_sg == 0 && __builtin_amdgcn_mbcnt_hi(~0u, __builtin_amdgcn_mbcnt_lo(~0u, 0u)) == 0u) {
        unsigned* bar = b.bar;
        __builtin_amdgcn_s_waitcnt(0);
        unsigned nloc = b.st[0], nx = b.st[1];
        if (nloc == 0u) { xcd_barrier_complete(bar, b.x, nloc, nx); b.st[0] = nloc; b.st[1] = nx; }
        const unsigned old = xb_add(&bar[XB_XSUB(b.x)], 1u);
        const unsigned gen = old / nloc;
        if (old + 1u == (gen + 1u) * nloc) {
            __builtin_amdgcn_fence(__ATOMIC_RELEASE, "agent");
            asm volatile("s_waitcnt vmcnt(0)" ::: "memory");
            const unsigned og = xb_add(&bar[XB_TOP], 1u);
            const unsigned tg = og / nx;
            if (og + 1u == (tg + 1u) * nx) xb_add(&bar[XB_TOPGEN], 1u);
            else XB_SPIN(xb_ld(&bar[XB_TOPGEN]) == tg, bar);
            __builtin_amdgcn_fence(__ATOMIC_ACQUIRE, "agent");
            xb_add(&bar[XB_XGEN(b.x)], 1u);
            asm volatile("s_waitcnt vmcnt(0)" ::: "memory");
        } else {
            XB_SPIN(xb_ld(&bar[XB_XGEN(b.x)]) == gen, bar);
            __builtin_amdgcn_fence(__ATOMIC_ACQUIRE, "agent");
            asm volatile("s_waitcnt vmcnt(0)" ::: "memory");
        }
    }
    __syncthreads();
}
constexpr size_t MiB = 1u << 20;
constexpr size_t WS_CTL = 0, CTL_ZERO_BYTES = 1 * MiB;
constexpr size_t WS_TAB = 1 * MiB;
constexpr size_t WS_WIN = 5 * MiB;
constexpr size_t WS_WOUT = 19 * MiB;
constexpr size_t WS_XRC = 23 * MiB;
constexpr size_t WS_HN = 27 * MiB;
constexpr size_t WS_MISC = 93 * MiB;
constexpr size_t WS_REG = 109 * MiB;
constexpr size_t WS_Z = WS_REG;
constexpr size_t WS_XS = WS_REG;
constexpr size_t WS_ACT = WS_REG + 148 * MiB;
constexpr size_t WS_WGU = WS_REG + 222 * MiB;
constexpr size_t WS_WD = WS_REG + 286 * MiB;
constexpr size_t MISC_LISTS = 7 * MiB; constexpr int LISTCAP = NTOK * 2;
constexpr size_t MISC_EID = 64 * 1024, MISC_GW = 384 * 1024, MISC_POSIDX = 704 * 1024, MISC_POSROW = 1024 * 1024;
constexpr size_t TAB_ROPE_HC = 0, TAB_ROPE_HS = 1 * MiB, TAB_ROPE_DC = 2 * MiB, TAB_ROPE_DS = 2 * MiB + 512 * 1024, TAB_LBV = 3 * MiB, TAB_GAM = 3 * MiB + 4096, TAB_LAM = 3 * MiB + 8192;
constexpr int CW_TMO = 0, CW_CODE = 1, CW_CNT = 64, CW_FILL = 128, CW_KMAX = 320;
constexpr int CW_BAR = 4096;
constexpr size_t TAB_RWT = 3 * MiB + 512 * 1024;
constexpr size_t TAB_MODV = 3 * MiB + 16384;
constexpr size_t MISC_MODVP = 2 * MiB;
constexpr int NWAVES = 8;
constexpr int RING_BYTES = 131072, LDSCTL_OFF = RING_BYTES, MISC_OFF = LDSCTL_OFF + 320, LDS_PB_OFF = LDSCTL_OFF + 1024, LDS_BYTES = 147456;

typedef unsigned u32x2 __attribute__((ext_vector_type(2)));
typedef unsigned u32x4 __attribute__((ext_vector_type(4)));
__device__ __forceinline__ float bf2f(unsigned h) { return __uint_as_float(h << 16); }
__device__ __forceinline__ float siluf(float v) { return v / (1.f + __expf(-v)); }
__device__ __forceinline__ float sigmf(float v) { return 1.f / (1.f + __expf(-v)); }
__device__ __forceinline__ float wave_sum(float v) {
#pragma unroll
    for (int o = 32; o > 0; o >>= 1) v += __shfl_xor(v, o);
    return v;
}
__device__ __forceinline__ int tok_of(int b, int r) { return r < SEQ ? b * SEQ + r : NLAT + b * CTX + (r - SEQ); }
__device__ __forceinline__ int mods_of_tok(int m) { return m < NLAT ? m / SEQ : 4; }

struct Args { const float* in[24]; float* out; unsigned char* ws; int ph_lo, ph_hi, li, pad; };
enum { I_X = 0, I_C, I_CTX, I_CCTX, I_WMOD, I_BMOD, I_N1G, I_N2G, I_WIN, I_RETDL, I_RETNG, I_GQG, I_GKG, I_HGLB, I_HGNG, I_DFLAM, I_DFNG, I_WOUT, I_RW, I_RB, I_WG, I_WU, I_WD, I_FING };

struct EpiRes {
    static constexpr bool PERM = false, AFTER_DRAIN = false;
    const float* src_lat; const float* src_ctx; float* dst_lat; float* dst_ctx; const float* g;
    __device__ __forceinline__ void operator()(const pg8::f32x4 (&acc)[2][2][4][2], const pg8::Unit& u, int wr, int wc, int fr, int fq) const {
        const bool lat = u.pm < NLAT / 256;
        const int s = lat ? (u.pm >> 5) : 4;
        const int rbase = lat ? u.pm * 256 : u.pm * 256 - NLAT;
        const float* src = (lat ? src_lat : src_ctx); float* dst = (lat ? dst_lat : dst_ctx);
        const int col0 = u.pn * 256 + wc * 32 + 4 * fq;
        const float* gv = g + (size_t)s * 6144 + col0;
        pg8::f32x4 gg[2][2];
#pragma unroll
        for (int bj = 0; bj < 2; ++bj)
#pragma unroll
            for (int n = 0; n < 2; ++n) gg[bj][n] = *(const GAS pg8::f32x4*)(gv + bj * 128 + n * 16);
#pragma unroll
        for (int ai = 0; ai < 2; ++ai)
#pragma unroll
            for (int m = 0; m < 4; ++m) {
                const size_t off = (size_t)(rbase + ai * 128 + wr * 64 + m * 16 + fr) * 1024 + col0;
#pragma unroll
                for (int bj = 0; bj < 2; ++bj)
#pragma unroll
                    for (int n = 0; n < 2; ++n) {
                        const pg8::f32x4 x = *(const GAS pg8::f32x4*)(src + off + bj * 128 + n * 16);
                        *(GAS pg8::f32x4*)(dst + off + bj * 128 + n * 16) = x + gg[bj][n] * acc[ai][bj][m][n];
                    }
            }
    }
};

struct EpiGateUp {
    static constexpr bool PERM = true, AFTER_DRAIN = false;
    bf16* O;
    __device__ __forceinline__ void operator()(const pg8::f32x4 (&acc)[2][2][4][2], const pg8::Unit& u, int wr, int wc, int fr, int fq) const {
        const int row0 = u.pm * 256 + wr * 64 + fr, col0 = (u.pn & 3) * 128 + wc * 32 + 8 * fq;
#pragma unroll
        for (int ai = 0; ai < 2; ++ai)
#pragma unroll
            for (int m = 0; m < 4; ++m) {
                float r[8];
#pragma unroll
                for (int n = 0; n < 2; ++n)
#pragma unroll
                    for (int i = 0; i < 4; ++i) { const float g = acc[ai][0][m][n][i], up = acc[ai][1][m][n][i]; r[n * 4 + i] = g * __builtin_amdgcn_rcpf(1.f + __expf(-g)) * up; }
                pg8::u32x4 w; w.x = pg8::cvt_pk_bf16(r[0], r[1]); w.y = pg8::cvt_pk_bf16(r[2], r[3]); w.z = pg8::cvt_pk_bf16(r[4], r[5]); w.w = pg8::cvt_pk_bf16(r[6], r[7]);
                *(GAS pg8::u32x4*)(O + (size_t)(row0 + ai * 128 + m * 16) * 512 + col0) = w;
            }
    }
};
struct MoeOrder {
    const volatile LAS int* pb; int G, c, nunits; const int* lists;
    __device__ __forceinline__ bool next(int i, pg8::Unit& u) const {
        const int L = i * G + c; if (L >= nunits) return false;
        int w = L; { const int q = nunits / 8, r = nunits % 8, x = w % 8, off = w / 8; w = (x < r ? x * (q + 1) : r * (q + 1) + (x - r) * q) + off; }
        const int rb = w >> 2, pn4 = w & 3;
        int e = 0;
#pragma unroll
        for (int j = 1; j < 32; ++j) e += (pb[j] <= rb) ? 1 : 0;
        u.pm = rb; u.pn = e * 4 + pn4; return true;
    }
    __device__ __forceinline__ int arow(const pg8::Unit& u, int rl) const { const int e = u.pn >> 2, idx = (u.pm - pb[e]) * 256 + rl; return idx < pb[64 + e] ? lists[(size_t)e * LISTCAP + idx] : 0; }
    __device__ __forceinline__ void a_ready(const pg8::Unit&) const {}
    __device__ __forceinline__ void done(const pg8::Unit&) const {}
};
typedef float f32x16 __attribute__((ext_vector_type(16)));
typedef __bf16 bf16x2_t __attribute__((ext_vector_type(2)));
typedef float f32x2_t __attribute__((ext_vector_type(2)));
constexpr size_t WS_VGT = WS_REG + 231 * MiB;
constexpr size_t WS_VDT = WS_REG + 240 * MiB;
constexpr size_t MISC_QNG = 4 * MiB, MISC_QND = 5 * MiB;
constexpr int NKEY = RB;
constexpr float LOG2E = 1.4426950408889634f;
constexpr int AT_KSTR = 144, AT_VSTR = 136, AT_KBYTES = 64 * AT_KSTR, AT_VBYTES = 64 * AT_VSTR, AT_BUF = AT_KBYTES + AT_VBYTES;
__device__ __forceinline__ int zrow_of_key(int b, int kap) { return kap < CTX ? NLAT + b * CTX + kap : b * SEQ + (kap - CTX); }
__device__ __forceinline__ unsigned cvtpk(float lo, float hi) { f32x2_t v = {lo, hi}; bf16x2_t r = __builtin_convertvector(v, bf16x2_t); return __builtin_bit_cast(unsigned, r); }
__device__ __forceinline__ float wave_max(float v) {
#pragma unroll
    for (int o = 32; o > 0; o >>= 1) v = fmaxf(v, __shfl_xor(v, o));
    return v;
}

__device__ __forceinline__ void ph_prep(const Args& a, int l, int vcu, int G, int wave_sg) {
    const int tid = phase_tid(), lane = tid & 63, wave = __builtin_amdgcn_readfirstlane(tid >> 6);
    const int gw = vcu * NWAVES + wave, NGW = G * NWAVES;
    bf16* Z = (bf16*)(a.ws + WS_Z);
    const float* HC = (const float*)(a.ws + WS_TAB + TAB_ROPE_HC); const float* HS = (const float*)(a.ws + WS_TAB + TAB_ROPE_HS);
    const float* DC = (const float*)(a.ws + WS_TAB + TAB_ROPE_DC); const float* DS = (const float*)(a.ws + WS_TAB + TAB_ROPE_DS);
    unsigned* kmaxw = (unsigned*)(a.ws + WS_CTL) + CW_KMAX + l * 64;
    GAS float* QNG = (GAS float*)(a.ws + WS_MISC + MISC_QNG); GAS float* QND = (GAS float*)(a.ws + WS_MISC + MISC_QND);
    for (int it = gw; it < (NTOK / 64) * 28; it += NGW) {
        const int tb = it / 28, u = it % 28;
        const int m = tb * 64 + lane; const bool lat = tb < NLAT / 64;
        int b, kap, t;
        if (lat) { b = m >> 13; t = m & (SEQ - 1); kap = CTX + t; } else { const int mm = m - NLAT; b = mm >> 8; kap = mm & (CTX - 1); t = 0; }
        int kind, hd, col;
        if (u < 4) { kind = 0; hd = u; col = 1024 + 64 * hd; }
        else if (u < 6) { kind = 1; hd = u - 4; col = 1280 + 64 * hd; }
        else if (u < 8) { kind = 2; hd = u - 6; col = 1408 + 64 * hd; }
        else if (u < 12) { kind = 3; hd = u - 8; col = 2816 + 64 * hd; }
        else if (u < 16) { kind = 4; hd = u - 12; col = 3072 + 64 * hd; }
        else if (u < 20) { kind = 5; hd = u - 16; col = 3328 + 64 * hd; }
        else if (u < 24) { kind = 6; hd = u - 20; col = 64 * hd; }
        else { kind = 7; hd = u - 24; col = 256 + 64 * hd; }
        GAS v4u* zp = (GAS v4u*)(Z + (size_t)m * INW + col);
        v4u raw[8];
#pragma unroll
        for (int c = 0; c < 8; ++c) raw[c] = zp[c];
        if (kind == 2 || kind == 5) {
            GAS bf16* VT = (kind == 2) ? (GAS bf16*)(a.ws + WS_VGT) + (size_t)((b * 2 + hd) * 64) * NKEY : (GAS bf16*)(a.ws + WS_VDT) + (size_t)((b * 4 + hd) * 64) * NKEY;
#pragma unroll
            for (int c = 0; c < 8; ++c)
#pragma unroll
                for (int i = 0; i < 4; ++i) { const unsigned w = raw[c][i];
                    VT[(size_t)(c * 8 + i * 2) * NKEY + kap] = (bf16)(w & 0xffffu); VT[(size_t)(c * 8 + i * 2 + 1) * NKEY + kap] = (bf16)(w >> 16); }
            continue;
        }
        float x[64];
#pragma unroll
        for (int c = 0; c < 8; ++c)
#pragma unroll
            for (int i = 0; i < 4; ++i) { x[c * 8 + i * 2] = __uint_as_float(raw[c][i] << 16); x[c * 8 + i * 2 + 1] = __uint_as_float(raw[c][i] & 0xffff0000u); }
        if (kind <= 1 || kind >= 6) {
            if (kind <= 1) {
                float ss = 0.f;
#pragma unroll
                for (int d = 0; d < 64; ++d) ss += x[d] * x[d];
                const float rstd = 1.0f / sqrtf(ss * (1.f / 64.f) + 1e-6f);
                const float* g = a.in[kind == 0 ? I_GQG : I_GKG] + l * 64;
#pragma unroll
                for (int d = 0; d < 64; ++d) x[d] = x[d] * rstd * g[d];
            }
            if (lat) {
                const GAS f32x4* cp = (const GAS f32x4*)(HC + (size_t)t * 32); const GAS f32x4* sp = (const GAS f32x4*)(HS + (size_t)t * 32);
#pragma unroll
                for (int c = 0; c < 8; ++c) { const f32x4 cs = cp[c], sn = sp[c];
#pragma unroll
                    for (int i = 0; i < 4; ++i) { const float x1 = x[c * 4 + i], x2 = x[c * 4 + i + 32]; x[c * 4 + i] = x1 * cs[i] - x2 * sn[i]; x[c * 4 + i + 32] = x2 * cs[i] + x1 * sn[i]; }
                    if (c == 3) asm volatile("" ::: "memory");     }
            }
            if (kind == 0 || kind == 6) {
                const float sc = (kind == 0) ? 0.125f * LOG2E : 0.125f;
#pragma unroll
                for (int d = 0; d < 64; ++d) x[d] *= sc;
            }
        } else {
            if (lat) {
                const GAS f32x4* cp = (const GAS f32x4*)(DC + (size_t)t * 16); const GAS f32x4* sp = (const GAS f32x4*)(DS + (size_t)t * 16);
#pragma unroll
                for (int c = 0; c < 4; ++c) { const f32x4 cs = cp[c], sn = sp[c];
#pragma unroll
                    for (int i = 0; i < 4; ++i)
#pragma unroll
                        for (int mp = 0; mp < 2; ++mp) { const int i1 = 32 * mp + c * 4 + i; const float x1 = x[i1], x2 = x[i1 + 16]; x[i1] = x1 * cs[i] - x2 * sn[i]; x[i1 + 16] = x2 * cs[i] + x1 * sn[i]; } }
            }
            if (kind == 3) {
#pragma unroll
                for (int d = 0; d < 64; ++d) x[d] *= 0.17677669529663687f * LOG2E;
            }
        }
        float n1 = 0.f, n2 = 0.f;
#pragma unroll
        for (int c = 0; c < 8; ++c) {
#pragma unroll
            for (int i = 0; i < 4; ++i) {
                const unsigned w = cvtpk(x[c * 8 + i * 2], x[c * 8 + i * 2 + 1]);
                const float r0 = __uint_as_float(w << 16), r1 = __uint_as_float(w & 0xffff0000u);
                if (c < 4) n1 += r0 * r0 + r1 * r1; else n2 += r0 * r0 + r1 * r1;
                raw[c][i] = w;
            }
        }
#pragma unroll
        for (int c = 0; c < 8; ++c) zp[c] = raw[c];
        if (kind == 0) QNG[(size_t)(b * 4 + hd) * NKEY + kap] = sqrtf(n1 + n2);
        else if (kind == 3) { QND[((size_t)(b * 4 + hd) * NKEY + kap) * 2] = sqrtf(n1); QND[((size_t)(b * 4 + hd) * NKEY + kap) * 2 + 1] = sqrtf(n2); }
        else if (kind == 1) { const float mx = wave_max(n1 + n2); if (lane == 0) atomicMax(kmaxw + b * 2 + hd, __float_as_uint(mx)); }
        else if (kind == 4) { const float m1 = wave_max(n1), m2 = wave_max(n2); if (lane == 0) { atomicMax(kmaxw + 8 + (b * 4 + hd) * 2, __float_as_uint(m1)); atomicMax(kmaxw + 8 + (b * 4 + hd) * 2 + 1, __float_as_uint(m2)); } }
    }
}

constexpr int AT2_STR = 144, AT2_TILE = 64 * AT2_STR, AT2_BUF = 2 * AT2_TILE;
#define AT_FADD(acc, x) ((acc) += (x))
template <bool DIFF>
__device__ __forceinline__ void attn_unit(const Args& a, int l, int b, int hq, int qb, LAS unsigned char* lds, int tid_in) {
    int tid = tid_in; asm volatile("" : "+v"(tid));
    const int lane = tid & 63, wave = __builtin_amdgcn_readfirstlane(tid >> 6), r32 = lane & 31, hi = lane >> 5;
    const bf16* Z = (const bf16*)(a.ws + WS_Z);
    const int kcol = DIFF ? 3072 + hq * 64 : 1280 + hq * 64, qcol = DIFF ? 2816 + hq * 64 : 1024 + hq * 128;
    const bf16* VT = DIFF ? (const bf16*)(a.ws + WS_VDT) + (size_t)((b * 4 + hq) * 64) * NKEY : (const bf16*)(a.ws + WS_VGT) + (size_t)((b * 2 + hq) * 64) * NKEY;
    const int nt = (qb == 0) ? CTX / 64 : NKEY / 64;
    const int kq = qb * 256 + wave * 32 + r32, mq = zrow_of_key(b, kq);
    LAS unsigned char* qlds = lds + 3 * AT2_BUF + wave * 8192 + lane * 16;
    bf16x8 qf[DIFF ? 4 : 8];
#pragma unroll
    for (int ds = 0; ds < (DIFF ? 4 : 8); ++ds) qf[ds] = *(const GAS bf16x8*)(Z + (size_t)mq * INW + qcol + 16 * ds + 8 * hi);
    if (DIFF) {
#pragma unroll
        for (int ds = 0; ds < 4; ++ds) *(LAS bf16x8*)(qlds + ds * 1024) = qf[ds];
    }
#define AT_Q(i) (DIFF ? *(const LAS bf16x8*)(qlds + (i) * 1024) : qf[(i) & (DIFF ? 3 : 7)])
    const unsigned* kmaxw = (const unsigned*)(a.ws + WS_CTL) + CW_KMAX + l * 64;
    float nb;
    if (!DIFF) {
        const float km = __uint_as_float(__hip_atomic_load(kmaxw + b * 2 + hq, RLX_AGENT));
        const GAS float* qn = (const GAS float*)(a.ws + WS_MISC + MISC_QNG) + (size_t)(b * 4 + 2 * hq) * NKEY + kq;
        nb = -fmaxf(qn[0], qn[NKEY]) * sqrtf(km);
    } else {
        const float km1 = __uint_as_float(__hip_atomic_load(kmaxw + 8 + (b * 4 + hq) * 2, RLX_AGENT)), km2 = __uint_as_float(__hip_atomic_load(kmaxw + 8 + (b * 4 + hq) * 2 + 1, RLX_AGENT));
        const GAS float* qn = (const GAS float*)(a.ws + WS_MISC + MISC_QND) + ((size_t)(b * 4 + hq) * NKEY + kq) * 2;
        nb = -fmaxf(qn[0] * sqrtf(km1), qn[1] * sqrtf(km2));
    }
    f32x16 nbv;
#pragma unroll
    for (int i = 0; i < 16; ++i) nbv[i] = nb;
    f32x16 o1[2], o2[2];
#pragma unroll
    for (int i = 0; i < 2; ++i) { o1[i] = (f32x16){}; o2[i] = (f32x16){}; }
    float l1 = 0.f, l2 = 0.f;
    const int srow = tid >> 3, sch = tid & 7;
    const unsigned voffK = (unsigned)((srow * INW + kcol + 8 * sch) * 2), voffV = (unsigned)((srow * NKEY + 8 * sch) * 2);
    const unsigned char* vt = (const unsigned char*)VT;
    const int wK = srow * AT2_STR + sch * 16, wV = AT2_TILE + srow * AT2_STR + (sch >> 1) * 32 + (sch & 1) * 8;
    const int rK = r32 * AT2_STR + hi * 16, rV = AT2_TILE + r32 * AT2_STR + hi * 16;
#define AT_GLOAD(t) do { const unsigned char* zt_ = (const unsigned char*)Z + (size_t)zrow_of_key(b, (t) * 64) * (INW * 2); kr = *(const GAS v4u*)(zt_ + voffK); vr = *(const GAS v4u*)(vt + (size_t)(t) * 128 + voffV); } while (0)
#define AT_LWRITE(slot) do { *(LAS v4u*)(lds + (slot) * AT2_BUF + wK) = kr; LAS u32x2* vd_ = (LAS u32x2*)(lds + (slot) * AT2_BUF + wV); vd_[0] = (u32x2){vr.x, vr.y}; vd_[2] = (u32x2){vr.z, vr.w}; } while (0)
#define AT_KFRAGS(dst, slot, kh) do { _Pragma("unroll") for (int ds_ = 0; ds_ < 4; ++ds_) dst[ds_] = *(const LAS bf16x8*)(lds + (slot) * AT2_BUF + rK + (kh) * 32 * AT2_STR + ds_ * 32); } while (0)
#define AT_VFRAGS(dst, slot, kh) do { _Pragma("unroll") for (int dh_ = 0; dh_ < 2; ++dh_) _Pragma("unroll") for (int sp_ = 0; sp_ < 2; ++sp_) dst[dh_ * 2 + sp_] = *(const LAS bf16x8*)(lds + (slot) * AT2_BUF + rV + dh_ * 32 * AT2_STR + ((kh) * 2 + sp_) * 32); } while (0)
#define AT_DOT(acc, w) acc = __builtin_amdgcn_fdot2_f32_bf16(__builtin_bit_cast(bf16x2_t, (unsigned)(w)), __builtin_bit_cast(bf16x2_t, 0x3F803F80u), acc, false)
#define AT_PACK(dst, s_, lsum) do { _Pragma("unroll") for (int sp_ = 0; sp_ < 2; ++sp_) { v4u w_; w_.x = cvtpk(s_[8 * sp_], s_[8 * sp_ + 1]); w_.y = cvtpk(s_[8 * sp_ + 2], s_[8 * sp_ + 3]); w_.z = cvtpk(s_[8 * sp_ + 4], s_[8 * sp_ + 5]); w_.w = cvtpk(s_[8 * sp_ + 6], s_[8 * sp_ + 7]); AT_DOT(lsum, w_.x); AT_DOT(lsum, w_.y); AT_DOT(lsum, w_.z); AT_DOT(lsum, w_.w); dst[sp_] = __builtin_bit_cast(bf16x8, w_); } } while (0)
#define AT_HALF(slot, kh, nslot, nkh, have_next) do { \
        f32x16 s1_, s2_; \
        if (!DIFF) { s1_ = __builtin_amdgcn_mfma_f32_32x32x16_bf16(kf[0], AT_Q(0), nbv, 0, 0, 0); s1_ = __builtin_amdgcn_mfma_f32_32x32x16_bf16(kf[1], AT_Q(1), s1_, 0, 0, 0); \
                     s2_ = __builtin_amdgcn_mfma_f32_32x32x16_bf16(kf[0], AT_Q(4), nbv, 0, 0, 0); s2_ = __builtin_amdgcn_mfma_f32_32x32x16_bf16(kf[1], AT_Q(5), s2_, 0, 0, 0); \
                     s1_ = __builtin_amdgcn_mfma_f32_32x32x16_bf16(kf[2], AT_Q(2), s1_, 0, 0, 0); s1_ = __builtin_amdgcn_mfma_f32_32x32x16_bf16(kf[3], AT_Q(3), s1_, 0, 0, 0); \
                     s2_ = __builtin_amdgcn_mfma_f32_32x32x16_bf16(kf[2], AT_Q(6), s2_, 0, 0, 0); s2_ = __builtin_amdgcn_mfma_f32_32x32x16_bf16(kf[3], AT_Q(7), s2_, 0, 0, 0); } \
        else { s1_ = __builtin_amdgcn_mfma_f32_32x32x16_bf16(kf[0], AT_Q(0), nbv, 0, 0, 0); s1_ = __builtin_amdgcn_mfma_f32_32x32x16_bf16(kf[1], AT_Q(1), s1_, 0, 0, 0); \
               s2_ = __builtin_amdgcn_mfma_f32_32x32x16_bf16(kf[2], AT_Q(2), nbv, 0, 0, 0); s2_ = __builtin_amdgcn_mfma_f32_32x32x16_bf16(kf[3], AT_Q(3), s2_, 0, 0, 0); } \
        bf16x8 vb_[4]; AT_VFRAGS(vb_, slot, kh); \
        if (have_next) AT_KFRAGS(kf, nslot, nkh); \
        asm volatile("" ::: "memory"); \
        bf16x8 pa1_[2], pa2_[2]; \
        _Pragma("unroll") for (int i_ = 0; i_ < 16; ++i_) { s1_[i_] = __builtin_amdgcn_exp2f(s1_[i_]); } \
        AT_PACK(pa1_, s1_, l1); \
        { _Pragma("unroll") for (int i_ = 0; i_ < 16; ++i_) { s2_[i_] = __builtin_amdgcn_exp2f(s2_[i_]); } AT_PACK(pa2_, s2_, l2); } \
        _Pragma("unroll") for (int dh_ = 0; dh_ < 2; ++dh_) _Pragma("unroll") for (int sp_ = 0; sp_ < 2; ++sp_) { \
            o1[dh_] = __builtin_amdgcn_mfma_f32_32x32x16_bf16(pa1_[sp_], vb_[dh_ * 2 + sp_], o1[dh_], 0, 0, 0); \
            o2[dh_] = __builtin_amdgcn_mfma_f32_32x32x16_bf16(pa2_[sp_], vb_[dh_ * 2 + sp_], o2[dh_], 0, 0, 0); } \
    } while (0)
    v4u kr, vr;
    AT_GLOAD(0); AT_LWRITE(0);
    AT_GLOAD(1); AT_LWRITE(1);
    __syncthreads();
    bf16x8 kf[4];
    AT_KFRAGS(kf, 0, 0);
    int s0 = 0, s1i = 1, s2i = 2;
    for (int kt = 0; kt < nt; ++kt) {
        const bool more1 = kt + 1 < nt, more2 = kt + 2 < nt;
        if (more2) AT_GLOAD(kt + 2);
        AT_HALF(s0, 0, s0, 1, true);
        AT_HALF(s0, 1, s1i, 0, more1);
        if (more2) AT_LWRITE(s2i);
        __syncthreads();
        const int t_ = s0; s0 = s1i; s1i = s2i; s2i = t_;
    }
#undef AT_Q
#undef AT_GLOAD
#undef AT_LWRITE
#undef AT_KFRAGS
#undef AT_VFRAGS
#undef AT_PACK
#undef AT_DOT
#undef AT_HALF
    int le = lane; asm volatile("" : "+v"(le));
    const int r32e = le & 31, hie = le >> 5;
    l1 += __shfl_xor(l1, 32); l2 += __shfl_xor(l2, 32);
    const float inv1 = 1.f / l1;
    GAS bf16* MIX = (GAS bf16*)(a.ws + WS_HN);
    if (!DIFF) {
        const float inv2g = 1.f / l2;
#pragma unroll
        for (int r = 0; r < 16; ++r) {
            const int qi = (r & 3) + 8 * (r >> 2) + 4 * hie;
            const float iv = __shfl(inv1, qi), iw = __shfl(inv2g, qi);
            GAS bf16* op = MIX + (size_t)zrow_of_key(b, qb * 256 + wave * 32 + qi) * 1024 + 256 + hq * 128 + r32e;
            op[0] = (bf16)f2bf(o1[0][r] * iv); op[32] = (bf16)f2bf(o1[1][r] * iv);
            op[64] = (bf16)f2bf(o2[0][r] * iw); op[96] = (bf16)f2bf(o2[1][r] * iw);
            asm volatile("" ::: "memory");
        }
    } else {
        const float lam = __hip_atomic_load((const GAS float*)(a.ws + WS_TAB + TAB_LAM) + l * 2, RLX_AGENT), li = __hip_atomic_load((const GAS float*)(a.ws + WS_TAB + TAB_LAM) + l * 2 + 1, RLX_AGENT);
        const float inv2 = lam / l2;
#pragma unroll
        for (int r = 0; r < 16; ++r) {
            const int qi = (r & 3) + 8 * (r >> 2) + 4 * hie;
            const float iv1 = __shfl(inv1, qi), iv2 = __shfl(inv2, qi);
            o1[0][r] = o1[0][r] * iv1 - o2[0][r] * iv2; o1[1][r] = o1[1][r] * iv1 - o2[1][r] * iv2;
        }
        const float g0 = a.in[I_DFNG][l * 64 + r32e] * (1.f - li), g1 = a.in[I_DFNG][l * 64 + 32 + r32e] * (1.f - li);
#pragma unroll
        for (int r = 0; r < 16; ++r) {
            const int qi = (r & 3) + 8 * (r >> 2) + 4 * hie;
            const float y0 = o1[0][r], y1 = o1[1][r];
            float ss = y0 * y0 + y1 * y1;
#pragma unroll
            for (int ofs = 16; ofs > 0; ofs >>= 1) ss += __shfl_xor(ss, ofs);
            const float rstd = 1.0f / sqrtf(ss * (1.f / 64.f) + 1e-6f);
            GAS bf16* op = MIX + (size_t)zrow_of_key(b, qb * 256 + wave * 32 + qi) * 1024 + 768 + hq * 64 + r32e;
            op[0] = (bf16)f2bf(y0 * rstd * g0); op[32] = (bf16)f2bf(y1 * rstd * g1);
            asm volatile("" ::: "memory");
        }
    }
}

__device__ __forceinline__ void ph_attn(const Args& a, int l, LAS unsigned char* lds, int G, int wave_sg) {
    const int tid = phase_tid();
    const int total = 768 + (l == 0 ? 24 : 0);
    for (int i = 0;; ++i) {
        const int L = i * G + (int)blockIdx.x;
        if (L >= total) break;
        bool isdiff; int b, hq, qb;
        if (L < 256) { const int x = L & 7; isdiff = false; b = x >> 1; hq = x & 1; qb = (L >> 3) + 1; }
        else if (L < 768) { const int Lp = L - 256, x = Lp & 7, j = (Lp >> 3) & 31, rep = Lp >> 8; isdiff = true; b = x >> 1; hq = 2 * (x & 1) + rep; qb = j + 1; }
        else if (L < 776) { const int c = L - 768; isdiff = false; b = c >> 1; hq = c & 1; qb = 0; }
        else { const int c = L - 776; isdiff = true; b = c >> 2; hq = c & 3; qb = 0; }
        if (isdiff) attn_unit<true>(a, l, b, hq, qb, lds, tid); else attn_unit<false>(a, l, b, hq, qb, lds, tid);
    }
}
constexpr size_t WS_LAS = WS_REG + 257 * MiB;
constexpr size_t WS_LAG = WS_REG + 323 * MiB;
constexpr int LA_STR = 160;
constexpr int U_QC = 0, U_QD = 64 * LA_STR, U_QX = 128 * LA_STR, U_KB = 176 * LA_STR, U_KD = 224 * LA_STR, U_A = 288 * LA_STR, U_DIR = 352 * LA_STR;
constexpr int U_VT = 2 * U_DIR, U_PART = U_VT + 64 * LA_STR, U_SS = U_PART + 4096;
static_assert(U_SS + 512 <= RING_BYTES, "LA LDS map");

__device__ __forceinline__ int la_chain(int mixer, int b, int h, int dir) { return ((mixer * 4 + b) * 4 + h) * 2 + dir; }
__device__ __forceinline__ int la_proc_chunk(int tc, int dir) { return dir == 0 ? tc : (tc < 4 ? 3 - tc : 135 - tc); }
__device__ __forceinline__ float bfbits(unsigned short h) { return __uint_as_float((unsigned)h << 16); }
__device__ __forceinline__ unsigned short hwbf(float v) { return (unsigned short)cvtpk(v, 0.f); }
__device__ __forceinline__ void lds_st_bf(LAS unsigned char* p, float v) { *(LAS unsigned short*)p = hwbf(v); }

struct La2Regs { unsigned short q0[8], q1[8], k0[8], k1[8], v[8]; float gam0, gam1, lb0, lb1; };
template <bool LA3>
__device__ __forceinline__ void la2_fetch(const Args& a, int l, int mixer, int b, int h, int tc, int wave, int lane, La2Regs& R) {
    const GAS bf16* zb = (const GAS bf16*)(a.ws + WS_Z) + (size_t)zrow_of_key(b, tc * 64) * INW + lane;
    const int qc = mixer == 0 ? h * 64 : 1536 + h * 64, kc0 = mixer == 0 ? 256 + h * 64 : 1792 + h * 64, kc1 = mixer == 0 ? 256 + h * 64 : 2048 + h * 64, vc = mixer == 0 ? 512 + h * 64 : 2304 + h * 64;
#pragma unroll
    for (int r = 0; r < 8; ++r) {
        const size_t t0 = (size_t)(8 * wave + r) * INW, t1 = (size_t)(63 - 8 * wave - r) * INW;
        R.k0[r] = zb[t0 + kc0]; R.k1[r] = zb[t1 + kc1]; R.v[r] = zb[t0 + vc];
        if (LA3) { R.q0[r] = zb[t0 + qc]; R.q1[r] = zb[t1 + qc]; }
    }
    R.gam0 = __hip_atomic_load((const GAS float*)(a.ws + WS_TAB + TAB_GAM) + (l * 2 + 0) * 4 + h, RLX_AGENT);
    R.gam1 = __hip_atomic_load((const GAS float*)(a.ws + WS_TAB + TAB_GAM) + (l * 2 + 1) * 4 + h, RLX_AGENT);
    R.lb0 = __hip_atomic_load((const GAS float*)(a.ws + WS_TAB + TAB_LBV) + (l * 2 + 0) * 256 + h * 64 + lane, RLX_AGENT);
    R.lb1 = __hip_atomic_load((const GAS float*)(a.ws + WS_TAB + TAB_LBV) + (l * 2 + 1) * 256 + h * 64 + lane, RLX_AGENT);
}
__device__ __forceinline__ void la2_gen_a(const unsigned short (&k)[8], float gam, float lb, int mixer, int dir, LAS unsigned char* lds, int wave, int lane, float (&la)[8], float (&kv)[8]) {
    const float lgam = __logf(gam);
    float s = 0.f;
#pragma unroll
    for (int r = 0; r < 8; ++r) {
        const float x = bfbits(k[r]);
        if (mixer == 0) { la[r] = lgam; kv[r] = x; }
        else { const float sg = __builtin_amdgcn_rcpf(1.f + __expf(-x)); la[r] = fmaxf(__logf(lb + (1.f - lb) * sg), -80.f); kv[r] = (1.f - lb) * (1.f - sg); }
        s += la[r];
    }
    *(LAS float*)(lds + U_PART + ((dir * 8 + wave) * 64 + lane) * 4) = s;
}
__device__ __forceinline__ void la2_vt(const unsigned short (&v)[8], LAS unsigned char* lds, int wave, int lane) {
    *(LAS v4u*)(lds + U_VT + lane * LA_STR + wave * 16) = (v4u){(unsigned)v[0] | ((unsigned)v[1] << 16), (unsigned)v[2] | ((unsigned)v[3] << 16), (unsigned)v[4] | ((unsigned)v[5] << 16), (unsigned)v[6] | ((unsigned)v[7] << 16)};
}

__device__ __forceinline__ void la1_item(const Args& a, int l, int mixer, int b, int h, int tc, LAS unsigned char* lds, int tid_in, La2Regs& R, int nxt  ) {
    int tid = tid_in; asm volatile("" : "+v"(tid));
    const int lane = tid & 63, wave = __builtin_amdgcn_readfirstlane(tid >> 6);
    float la0[8], kv0[8], la1[8], kv1[8];
    la2_gen_a(R.k0, R.gam0, R.lb0, mixer, 0, lds, wave, lane, la0, kv0);
    la2_gen_a(R.k1, R.gam1, R.lb1, mixer, 1, lds, wave, lane, la1, kv1);
    la2_vt(R.v, lds, wave, lane);
    if (nxt >= 0) { const int ch2 = nxt / 132; la2_fetch<false>(a, l, ch2 >> 4, (ch2 >> 2) & 3, ch2 & 3, nxt % 132, wave, lane, R); }
    __syncthreads();
#pragma unroll
    for (int dir = 0; dir < 2; ++dir) {
        float base = 0.f, ctot = 0.f;
#pragma unroll
        for (int w2 = 0; w2 < 8; ++w2) { const float pv = *(const LAS float*)(lds + U_PART + ((dir * 8 + w2) * 64 + lane) * 4); ctot += pv; if (w2 < wave) base += pv; }
        float c = base; unsigned short hb[8];
#pragma unroll
        for (int r = 0; r < 8; ++r) { c += dir ? la1[r] : la0[r]; hb[r] = hwbf((dir ? kv1[r] : kv0[r]) * __expf(ctot - c)); }
        if (dir == 0) *(LAS v4u*)(lds + 0 * U_DIR + lane * LA_STR + wave * 16) = (v4u){(unsigned)hb[0] | ((unsigned)hb[1] << 16), (unsigned)hb[2] | ((unsigned)hb[3] << 16), (unsigned)hb[4] | ((unsigned)hb[5] << 16), (unsigned)hb[6] | ((unsigned)hb[7] << 16)};
        else *(LAS v4u*)(lds + 1 * U_DIR + lane * LA_STR + (7 - wave) * 16) = (v4u){(unsigned)hb[7] | ((unsigned)hb[6] << 16), (unsigned)hb[5] | ((unsigned)hb[4] << 16), (unsigned)hb[3] | ((unsigned)hb[2] << 16), (unsigned)hb[1] | ((unsigned)hb[0] << 16)};
        const size_t idx = (size_t)la_chain(mixer, b, h, dir) * 132 + la_proc_chunk(tc, dir);
        if (wave == 0) ((GAS float*)(a.ws + WS_LAG))[idx * 64 + lane] = __expf(ctot);
    }
    __syncthreads();
    {
        const int r16 = lane & 15, g = lane >> 4, mi = wave & 3;
#pragma unroll
        for (int rep = 0; rep < 4; ++rep) {
            const int dir = rep >> 1, ni = 2 * (wave >> 2) + (rep & 1);
            pg8::f32x4 acc = {0.f, 0.f, 0.f, 0.f};
#pragma unroll
            for (int ks = 0; ks < 2; ++ks) {
                const bf16x8 af = *(const LAS bf16x8*)(lds + U_VT + (16 * mi + r16) * LA_STR + ks * 64 + g * 16);
                const bf16x8 bfr = *(const LAS bf16x8*)(lds + dir * U_DIR + (16 * ni + r16) * LA_STR + ks * 64 + g * 16);
                acc = __builtin_amdgcn_mfma_f32_16x16x32_bf16(af, bfr, acc, 0, 0, 0);
            }
            GAS bf16* ST = (GAS bf16*)(a.ws + WS_LAS) + ((size_t)la_chain(mixer, b, h, dir) * 132 + la_proc_chunk(tc, dir)) * 4096;
#pragma unroll
            for (int rg = 0; rg < 4; ++rg) ST[(16 * mi + 4 * g + rg) * 64 + 16 * ni + r16] = (bf16)hwbf(acc[rg]);
        }
    }
    __syncthreads();
}

__device__ __forceinline__ void ph_la_scan(const Args& a, int vcu, int G, int wave_sg) {
    const int tid = phase_tid();
    unsigned* LAS_ = (unsigned*)(a.ws + WS_LAS); const float* LAGp = (const float*)(a.ws + WS_LAG);
    typedef float f32x2s __attribute__((ext_vector_type(2)));
    for (int p = vcu * 512 + tid; p < 64 * 2048; p += G * 512) {
        const int chain = p >> 11, w = p & 2047, d0 = (w & 31) * 2;
        GAS unsigned* st = (GAS unsigned*)LAS_ + (size_t)chain * 132 * 2048 + w;
        const GAS float* gp = (const GAS float*)LAGp + (size_t)chain * 132 * 64 + d0;
        float s0 = 0.f, s1 = 0.f;
        for (int c0 = 0; c0 < 132; c0 += 12) {
            unsigned x[12]; f32x2s g[12];
#pragma unroll
            for (int j = 0; j < 12; ++j) { x[j] = st[(size_t)(c0 + j) * 2048]; g[j] = *(const GAS f32x2s*)(gp + (c0 + j) * 64); }
#pragma unroll
            for (int j = 0; j < 12; ++j) {
                st[(size_t)(c0 + j) * 2048] = pk2(s0, s1);
                s0 = g[j].x * s0 + __uint_as_float(x[j] << 16); s1 = g[j].y * s1 + __uint_as_float(x[j] & 0xffff0000u);
            }
        }
    }
}

__device__ __forceinline__ void la3_gen_b(const unsigned short (&q)[8], const float (&la)[8], const float (&kv)[8], int dir, LAS unsigned char* lds, int wave, int lane) {
    float pr[8];
#pragma unroll
    for (int w2 = 0; w2 < 8; ++w2) pr[w2] = *(const LAS float*)(lds + U_PART + ((dir * 8 + w2) * 64 + lane) * 4);
    const float R1 = pr[0] + pr[1], R2 = R1 + pr[2] + pr[3], R3 = R2 + pr[4] + pr[5];
    float base = 0.f;
#pragma unroll
    for (int w2 = 0; w2 < 8; ++w2) if (w2 < wave) base += pr[w2];
    const int sa = wave >> 1;
    const float Ra = sa == 0 ? 0.f : sa == 1 ? R1 : sa == 2 ? R2 : R3;
    const float Rn = sa == 0 ? R1 : sa == 1 ? R2 : R3;
    LAS unsigned char* T = lds + dir * U_DIR;
    float c = base;
#pragma unroll
    for (int r = 0; r < 8; ++r) {
        const int i = 8 * wave + r;
        c += la[r];
        const float qv = bfbits(q[r]);
        lds_st_bf(T + U_QC + i * LA_STR + lane * 2, qv * __expf(c));
        lds_st_bf(T + U_QD + i * LA_STR + lane * 2, qv * __expf(c - Ra));
        if (sa == 2) lds_st_bf(T + U_QX + (i & 15) * LA_STR + lane * 2, qv * __expf(c - R1));
        if (sa == 3) { lds_st_bf(T + U_QX + (16 + (i & 15)) * LA_STR + lane * 2, qv * __expf(c - R1)); lds_st_bf(T + U_QX + (32 + (i & 15)) * LA_STR + lane * 2, qv * __expf(c - R2)); }
        if (sa <= 2) lds_st_bf(T + U_KB + i * LA_STR + lane * 2, kv[r] * __expf(Rn - c));
        lds_st_bf(T + U_KD + i * LA_STR + lane * 2, kv[r] * __expf(fminf(Ra - c, 80.f)));
    }
}
__device__ __forceinline__ void la3_item(const Args& a, int l, int mixer, int b, int h, int tc, LAS unsigned char* lds, int tid_in, La2Regs& R, int nmixer, int nb, int nh, int ntc  ) {
    int tid = tid_in; asm volatile("" : "+v"(tid));
    const int lane = tid & 63, wave = __builtin_amdgcn_readfirstlane(tid >> 6);
    const int r16 = lane & 15, g = lane >> 4, mi = wave & 3, ni0 = 2 * (wave >> 2);
    v4u sfr[2][2][2];
#pragma unroll
    for (int dir = 0; dir < 2; ++dir) {
        const GAS bf16* ST = (const GAS bf16*)(a.ws + WS_LAS) + ((size_t)la_chain(mixer, b, h, dir) * 132 + la_proc_chunk(tc, dir)) * 4096;
#pragma unroll
        for (int nn = 0; nn < 2; ++nn)
#pragma unroll
            for (int ks = 0; ks < 2; ++ks) sfr[dir][nn][ks] = *(const GAS v4u*)(ST + (16 * (ni0 + nn) + r16) * 64 + 32 * ks + 8 * g);
    }
    const size_t zrow0 = (size_t)zrow_of_key(b, tc * 64);
    unsigned short gx[2][4];
#pragma unroll
    for (int nn = 0; nn < 2; ++nn)
#pragma unroll
        for (int rg = 0; rg < 4; ++rg) gx[nn][rg] = ((const GAS bf16*)(a.ws + WS_Z))[(zrow0 + 16 * mi + 4 * g + rg) * INW + (mixer == 0 ? 768 : 2560) + h * 64 + 16 * (ni0 + nn) + r16];
    float la0[8], kv0[8], la1[8], kv1[8];
    la2_gen_a(R.k0, R.gam0, R.lb0, mixer, 0, lds, wave, lane, la0, kv0);
    la2_gen_a(R.k1, R.gam1, R.lb1, mixer, 1, lds, wave, lane, la1, kv1);
    la2_vt(R.v, lds, wave, lane);
    __syncthreads();
    la3_gen_b(R.q0, la0, kv0, 0, lds, wave, lane);
    la3_gen_b(R.q1, la1, kv1, 1, lds, wave, lane);
    if (ntc >= 0) la2_fetch<true>(a, l, nmixer, nb, nh, ntc, wave, lane, R);
    __syncthreads();
#pragma unroll
    for (int rep = 0; rep < 4; ++rep) {
        const int dir = rep >> 1, blk = wave + 8 * (rep & 1), ba = blk >> 2, bb = blk & 3;
        const LAS unsigned char* T = lds + dir * U_DIR;
        pg8::f32x4 acc = {0.f, 0.f, 0.f, 0.f};
        if (bb <= ba) {
            int qoff, koff;
            if (bb == ba) { qoff = U_QD + 16 * ba * LA_STR; koff = U_KD + 16 * ba * LA_STR; }
            else if (bb == ba - 1) { qoff = U_QD + 16 * ba * LA_STR; koff = U_KB + 16 * bb * LA_STR; }
            else { qoff = U_QX + 16 * (ba == 2 ? 0 : 1 + bb) * LA_STR; koff = U_KB + 16 * bb * LA_STR; }
#pragma unroll
            for (int ks = 0; ks < 2; ++ks) {
                const bf16x8 af = *(const LAS bf16x8*)(T + qoff + r16 * LA_STR + ks * 64 + g * 16);
                const bf16x8 bfr = *(const LAS bf16x8*)(T + koff + r16 * LA_STR + ks * 64 + g * 16);
                acc = __builtin_amdgcn_mfma_f32_16x16x32_bf16(af, bfr, acc, 0, 0, 0);
            }
        }
#pragma unroll
        for (int rg = 0; rg < 4; ++rg) {
            const int il = 4 * g + rg, jc = 16 * bb + r16;
            const float v = (bb < ba || (bb == ba && r16 <= il)) ? acc[rg] : 0.f;
            lds_st_bf(lds + dir * U_DIR + U_A + (16 * ba + il) * LA_STR + (dir ? 63 - jc : jc) * 2, v);
        }
    }
    __syncthreads();
    float tot[2][4];
#pragma unroll
    for (int nn = 0; nn < 2; ++nn) {
        pg8::f32x4 acc0 = {0.f, 0.f, 0.f, 0.f}, acc1 = {0.f, 0.f, 0.f, 0.f};
#pragma unroll
        for (int ks = 0; ks < 2; ++ks) {
            const bf16x8 vf = *(const LAS bf16x8*)(lds + U_VT + (16 * (ni0 + nn) + r16) * LA_STR + ks * 64 + g * 16);
            const bf16x8 a0 = *(const LAS bf16x8*)(lds + U_A + (16 * mi + r16) * LA_STR + ks * 64 + g * 16);
            const bf16x8 a1 = *(const LAS bf16x8*)(lds + U_DIR + U_A + (16 * (3 - mi) + r16) * LA_STR + ks * 64 + g * 16);
            acc0 = __builtin_amdgcn_mfma_f32_16x16x32_bf16(a0, vf, acc0, 0, 0, 0);
            acc1 = __builtin_amdgcn_mfma_f32_16x16x32_bf16(a1, vf, acc1, 0, 0, 0);
        }
#pragma unroll
        for (int ks = 0; ks < 2; ++ks) {
            const bf16x8 q0f = *(const LAS bf16x8*)(lds + U_QC + (16 * mi + r16) * LA_STR + ks * 64 + g * 16);
            const bf16x8 q1f = *(const LAS bf16x8*)(lds + U_DIR + U_QC + (16 * (3 - mi) + r16) * LA_STR + ks * 64 + g * 16);
            acc0 = __builtin_amdgcn_mfma_f32_16x16x32_bf16(q0f, __builtin_bit_cast(bf16x8, sfr[0][nn][ks]), acc0, 0, 0, 0);
            acc1 = __builtin_amdgcn_mfma_f32_16x16x32_bf16(q1f, __builtin_bit_cast(bf16x8, sfr[1][nn][ks]), acc1, 0, 0, 0);
        }
#pragma unroll
        for (int rg = 0; rg < 4; ++rg) tot[nn][rg] = acc0[rg] + __shfl_xor(acc1[3 - rg], 48);
    }
    {
        float ssq[4];
#pragma unroll
        for (int rg = 0; rg < 4; ++rg) { float s = tot[0][rg] * tot[0][rg] + tot[1][rg] * tot[1][rg]; s += __shfl_xor(s, 1); s += __shfl_xor(s, 2); s += __shfl_xor(s, 4); s += __shfl_xor(s, 8); ssq[rg] = s; }
        if (r16 == 0) {
#pragma unroll
            for (int rg = 0; rg < 4; ++rg) *(LAS float*)(lds + U_SS + ((16 * mi + 4 * g + rg) * 2 + (wave >> 2)) * 4) = ssq[rg];
        }
    }
    __syncthreads();
    {
        const float* ng = a.in[mixer == 0 ? I_RETNG : I_HGNG] + l * 64;
        GAS bf16* MIX = (GAS bf16*)(a.ws + WS_HN);
#pragma unroll
        for (int rg = 0; rg < 4; ++rg) {
            const int row = 16 * mi + 4 * g + rg;
            const float ss = *(const LAS float*)(lds + U_SS + (row * 2) * 4) + *(const LAS float*)(lds + U_SS + (row * 2 + 1) * 4);
            const float rstd = __builtin_amdgcn_rsqf(ss * (1.f / 64.f) + 1e-6f);
#pragma unroll
            for (int nn = 0; nn < 2; ++nn) {
                const int e = 16 * (ni0 + nn) + r16;
                const float gv = bfbits(gx[nn][rg]);
                MIX[(zrow0 + row) * 1024 + (mixer == 0 ? 0 : 512) + h * 64 + e] = (bf16)hwbf(tot[nn][rg] * rstd * ng[e] * gv * __builtin_amdgcn_rcpf(1.f + __expf(-gv)));
            }
        }
    }
    __syncthreads();
}

__device__ __forceinline__ void ph_la1(const Args& a, int l, LAS unsigned char* lds, int G, int wave_sg) {
    const int tid = phase_tid(), lane0 = tid & 63, wave0 = __builtin_amdgcn_readfirstlane(tid >> 6);
    La2Regs R;
    int it = (int)blockIdx.x;
    if (it < 32 * 132) { const int ch = it / 132; la2_fetch<false>(a, l, ch >> 4, (ch >> 2) & 3, ch & 3, it % 132, wave0, lane0, R); }
    for (; it < 32 * 132; it += G) {
        const int tc = it % 132, ch = it / 132, h = ch & 3, b = (ch >> 2) & 3, mixer = ch >> 4;
        la1_item(a, l, mixer, b, h, tc, lds, tid, R, it + G < 32 * 132 ? it + G : -1);
    }
}
__device__ __forceinline__ void ph_la3(const Args& a, int l, LAS unsigned char* lds, int G, int wave_sg) {
    const int tid = phase_tid(), lane0 = tid & 63, wave0 = __builtin_amdgcn_readfirstlane(tid >> 6);
    const int tc0 = (l == 0) ? 0 : 4, ntc = 132 - tc0, total = 32 * ntc;
    La2Regs R;
    int it = (int)blockIdx.x;
    if (it < total) { const int ch = it / ntc; la2_fetch<true>(a, l, ch >> 4, (ch >> 2) & 3, ch & 3, tc0 + it % ntc, wave0, lane0, R); }
    for (; it < total; it += G) {
        const int tc = tc0 + it % ntc, ch = it / ntc, h = ch & 3, b = (ch >> 2) & 3, mixer = ch >> 4;
        const int nx = it + G; const int nch = nx / ntc;
        la3_item(a, l, mixer, b, h, tc, lds, tid, R, nch >> 4, (nch >> 2) & 3, nch & 3, nx < total ? tc0 + nx % ntc : -1);
    }
}
__device__ __forceinline__ void transpose_item(const float* W, int K, int N, bf16* WT, int row_off, LAS float* scr, int item, int lane) {
    const int nblk = N / 32, kb = item / nblk, nb = item % nblk, k0 = 64 * kb, n0 = 32 * nb;
    {
        f32x4 t[8];
#pragma unroll
        for (int i = 0; i < 8; ++i) t[i] = *(const GAS f32x4*)(W + (size_t)(k0 + 8 * i + (lane >> 3)) * N + n0 + 4 * (lane & 7));
#pragma unroll
        for (int i = 0; i < 8; ++i) { LAS float* d = scr + (8 * i + (lane >> 3)) * 33 + 4 * (lane & 7); d[0] = t[i].x; d[1] = t[i].y; d[2] = t[i].z; d[3] = t[i].w; }
    }
    LDS_WAIT(); asm volatile("" ::: "memory");
    const int c = lane & 7;
#pragma unroll
    for (int j = 0; j < 4; ++j) { const int n = (lane >> 3) + 8 * j; const LAS float* s = scr + (8 * c) * 33 + n;
        v4u o; o.x = pk2(s[0 * 33], s[1 * 33]); o.y = pk2(s[2 * 33], s[3 * 33]); o.z = pk2(s[4 * 33], s[5 * 33]); o.w = pk2(s[6 * 33], s[7 * 33]);
        *(GAS v4u*)(WT + (size_t)(row_off + n0 + n) * K + k0 + 8 * c) = o; }
    LDS_WAIT(); asm volatile("" ::: "memory");
}

__device__ __forceinline__ void ph_prologue(const Args& a, LAS unsigned char* lds, int vcu, int G, int wave_sg) {
    const int tid = phase_tid(), lane = tid & 63, wave = __builtin_amdgcn_readfirstlane(tid >> 6);
    unsigned char* ws = a.ws;
    LAS float* sl = (LAS float*)lds;
    for (int i = tid; i < 5 * 1024; i += 512) { const float v = i < 4096 ? a.in[I_C][i] : a.in[I_CCTX][i - 4096]; sl[i] = siluf(v); }
    __syncthreads();
    {
        float* modvp = (float*)(ws + WS_MISC + MISC_MODVP);
        for (int gid = vcu * 512 + tid; gid < 8 * 12288; gid += G * 512) {
            const int kq = gid / 12288, rem = gid % 12288, l = rem / 6144, n = rem % 6144;
            const float* w = a.in[I_WMOD] + ((size_t)l * 1024 + kq * 128) * 6144 + n;
            float acc[5];
#pragma unroll
            for (int s = 0; s < 5; ++s) acc[s] = 0.f;
#pragma unroll 8
            for (int k = 0; k < 128; ++k) { const float wv = w[(size_t)k * 6144];
#pragma unroll
                for (int s = 0; s < 5; ++s) acc[s] += sl[s * 1024 + kq * 128 + k] * wv; }
#pragma unroll
            for (int s = 0; s < 5; ++s) modvp[(size_t)kq * 61440 + (size_t)(l * 5 + s) * 6144 + n] = acc[s];
        }
    }
    {
        float* hc = (float*)(ws + WS_TAB + TAB_ROPE_HC); float* hs = (float*)(ws + WS_TAB + TAB_ROPE_HS);
        float* dc = (float*)(ws + WS_TAB + TAB_ROPE_DC); float* ds = (float*)(ws + WS_TAB + TAB_ROPE_DS);
        for (int gid = vcu * 512 + tid; gid < SEQ * 32; gid += G * 512) {
            const int t = gid >> 5, i = gid & 31, j = i & 15;
            const float pos = (i < 16) ? (float)(t >> 6) : (float)(t & 63);
            const float ang = pos * powf(10000.f, -(float)j / 16.f);
            hc[gid] = cosf(ang); hs[gid] = sinf(ang);
        }
        for (int gid = vcu * 512 + tid; gid < SEQ * 16; gid += G * 512) {
            const int t = gid >> 4, i = gid & 15, j = i & 7;
            const float pos = (i < 8) ? (float)(t >> 6) : (float)(t & 63);
            const float ang = pos * powf(10000.f, -(float)j / 8.f);
            dc[gid] = cosf(ang); ds[gid] = sinf(ang);
        }
        if (vcu == 0) {
            float* lbv = (float*)(ws + WS_TAB + TAB_LBV); float* gam = (float*)(ws + WS_TAB + TAB_GAM); float* lam = (float*)(ws + WS_TAB + TAB_LAM);
            for (int gid = tid; gid < 1024; gid += 512) {
                const int l = gid >> 9, dir = (gid >> 8) & 1, w = gid & 255;
                const float x0 = a.in[I_HGLB][(dir * 2 + 0) * 256 + w], x1 = a.in[I_HGLB][(dir * 2 + 1) * 256 + w];
                const float mx = fmaxf(x0, x1), e0 = expf(x0 - mx), e1 = expf(x1 - mx);
                lbv[(l * 2 + dir) * 256 + w] = (l == 0) ? 0.f : e1 / (e0 + e1);
            }
            if (tid < 16) gam[tid] = 1.f / (1.f + expf(-a.in[I_RETDL][tid]));
            if (tid < 2) {
                const int l = tid; float s01 = 0.f, s23 = 0.f;
                for (int d = 0; d < 32; ++d) { s01 += a.in[I_DFLAM][(l * 4 + 0) * 32 + d] * a.in[I_DFLAM][(l * 4 + 1) * 32 + d]; s23 += a.in[I_DFLAM][(l * 4 + 2) * 32 + d] * a.in[I_DFLAM][(l * 4 + 3) * 32 + d]; }
                const float li = 0.8f - 0.6f * expf(-0.3f * (float)l);
                lam[l * 2] = expf(s01) - expf(s23) + li; lam[l * 2 + 1] = li;
            }
        }
    }
    __syncthreads();
    {
        LAS float* scr = (LAS float*)(lds + wave * 16384);
        const int gw = vcu * NWAVES + wave, NGW = G * NWAVES;
        constexpr int I_IN = (1024 / 64) * (INW / 32), I_OUT = (1024 / 64) * (1024 / 32);
        for (int it = gw; it < 2 * (I_IN + I_OUT); it += NGW) {
            const int l = it / (I_IN + I_OUT); int r = it % (I_IN + I_OUT);
            if (r < I_IN) transpose_item(a.in[I_WIN] + (size_t)l * 1024 * INW, 1024, INW, (bf16*)(ws + WS_WIN) + (size_t)l * INW * 1024, 0, scr, r, lane);
            else transpose_item(a.in[I_WOUT] + (size_t)l * 1024 * 1024, 1024, 1024, (bf16*)(ws + WS_WOUT) + (size_t)l * 1024 * 1024, 0, scr, r - I_IN, lane);
        }
    }
}

__device__ __forceinline__ float modv_from_partials(const Args& a, int idx  ) {
    const GAS float* pp = (const GAS float*)(a.ws + WS_MISC + MISC_MODVP) + idx;
    float v = a.in[I_BMOD][(idx / 30720) * 6144 + idx % 6144];
#pragma unroll
    for (int kq = 0; kq < 8; ++kq) v += pp[(size_t)kq * 61440];
    return v;
}
__device__ __forceinline__ void moe_block_prefix(const Args& a, int l, LAS unsigned char* lds, int tid) {
    volatile LAS int* pb = (volatile LAS int*)(lds + LDS_PB_OFF);
    if (tid < 64) {
        const int c = (tid < NE) ? __hip_atomic_load((const int*)(a.ws + WS_CTL) + CW_CNT + l * NE + tid, RLX_AGENT) : 0;
        int nb = (c + 255) >> 8, incl = nb;
#pragma unroll
        for (int o = 1; o < 32; o <<= 1) { const int t = __shfl_up(incl, o); if ((tid & 63) >= o) incl += t; }
        if (tid < NE) { pb[tid] = incl - nb; pb[64 + tid] = c; }
        if (tid == NE - 1) pb[NE] = incl;
    }
    __syncthreads();
}
__device__ __forceinline__ float* xr_row(const Args& a, int m) { return m < NLAT ? a.out + (size_t)m * 1024 : (float*)(a.ws + WS_XRC) + (size_t)(m - NLAT) * 1024; }
__device__ __forceinline__ f32x4 bf4_to_f32(u32x2 w) { return (f32x4){__uint_as_float(w.x << 16), __uint_as_float(w.x & 0xffff0000u), __uint_as_float(w.y << 16), __uint_as_float(w.y & 0xffff0000u)}; }
struct CombIdx { int e0, e1, p0, p1; float w0, w1; };
struct CombDat { f32x4 x[4]; u32x2 y0[4], y1[4]; };
__device__ __forceinline__ void comb_idx(const Args& a, int m, CombIdx& I) {
    const int* eidp = (const int*)(a.ws + WS_MISC + MISC_EID); const int* posidx = (const int*)(a.ws + WS_MISC + MISC_POSIDX); const float* gw = (const float*)(a.ws + WS_MISC + MISC_GW);
    I.e0 = __hip_atomic_load(eidp + 2 * m, RLX_AGENT); I.e1 = __hip_atomic_load(eidp + 2 * m + 1, RLX_AGENT);
    I.p0 = __hip_atomic_load(posidx + 2 * m, RLX_AGENT); I.p1 = __hip_atomic_load(posidx + 2 * m + 1, RLX_AGENT);
    I.w0 = __hip_atomic_load(gw + 2 * m, RLX_AGENT); I.w1 = __hip_atomic_load(gw + 2 * m + 1, RLX_AGENT);
}
__device__ __forceinline__ void comb_dat(const Args& a, int m, int lane, LAS unsigned char* lds, const CombIdx& I, CombDat& D) {
    const volatile LAS int* pb = (const volatile LAS int*)(lds + LDS_PB_OFF);
    const int r0 = pb[I.e0] * 256 + I.p0, r1 = pb[I.e1] * 256 + I.p1;
    const GAS f32x4* xr = (const GAS f32x4*)xr_row(a, m) + lane;
    const GAS u32x2* y0 = (const GAS u32x2*)((const bf16*)(a.ws + WS_XS) + (size_t)r0 * 1024) + lane;
    const GAS u32x2* y1 = (const GAS u32x2*)((const bf16*)(a.ws + WS_XS) + (size_t)r1 * 1024) + lane;
#pragma unroll
    for (int j = 0; j < 4; ++j) { D.x[j] = xr[64 * j]; D.y0[j] = y0[64 * j]; D.y1[j] = y1[64 * j]; }
}
__device__ __forceinline__ void comb_apply(const Args& a, int lprev, int m, int lane, const CombIdx& I, const CombDat& D, f32x4 (&v)[4]) {
    const GAS f32x4* g2 = (const GAS f32x4*)((const float*)(a.ws + WS_TAB + TAB_MODV) + (size_t)(lprev * 5 + mods_of_tok(m)) * 6144 + 5120) + lane;
#pragma unroll
    for (int j = 0; j < 4; ++j) v[j] = D.x[j] + g2[64 * j] * (bf4_to_f32(D.y0[j]) * I.w0 + bf4_to_f32(D.y1[j]) * I.w1);
}
__device__ __forceinline__ void ph_rowprep(const Args& a, int l, LAS unsigned char* lds, int vcu, int G, int wave_sg) {
    const int tid = phase_tid(), lane = tid & 63, wave = __builtin_amdgcn_readfirstlane(tid >> 6);
    const int gw = vcu * NWAVES + wave, NGW = G * NWAVES;
    GAS float* modv = (GAS float*)(a.ws + WS_TAB + TAB_MODV);
    LAS float* mvl = (LAS float*)lds;
    if (l == 0) {
        for (int i = vcu * 512 + tid; i < 61440; i += G * 512) modv[i] = modv_from_partials(a, i);
        for (int i = tid; i < 5 * 2048; i += 512) mvl[i] = modv_from_partials(a, (i / 2048) * 6144 + (i % 2048));
    } else {
        for (int i = tid; i < 5 * 2048; i += 512) mvl[i] = modv[(size_t)(l * 5 + i / 2048) * 6144 + (i % 2048)];
    }
    __syncthreads();
    bf16* HN = (bf16*)(a.ws + WS_HN);
    const float* ng = a.in[I_N1G] + l * 1024;
    for (int m0 = gw; m0 < NTOK; m0 += 2 * NGW) {
        const int m1 = m0 + NGW; const bool two = m1 < NTOK;
        f32x4 va[4], vb[4];
        if (l == 0) {
            const GAS f32x4* xa = (const GAS f32x4*)(m0 < NLAT ? a.in[I_X] + (size_t)m0 * 1024 : a.in[I_CTX] + (size_t)(m0 - NLAT) * 1024) + lane;
            const int m1c = two ? m1 : m0;
            const GAS f32x4* xb = (const GAS f32x4*)(m1c < NLAT ? a.in[I_X] + (size_t)m1c * 1024 : a.in[I_CTX] + (size_t)(m1c - NLAT) * 1024) + lane;
#pragma unroll
            for (int j = 0; j < 4; ++j) { va[j] = xa[64 * j]; vb[j] = xb[64 * j]; }
        } else {
            const int m1c = two ? m1 : m0;
            CombIdx Ia, Ib; comb_idx(a, m0, Ia); comb_idx(a, m1c, Ib);
            CombDat Da, Db; comb_dat(a, m0, lane, lds, Ia, Da); comb_dat(a, m1c, lane, lds, Ib, Db);
            comb_apply(a, l - 1, m0, lane, Ia, Da, va); comb_apply(a, l - 1, m1c, lane, Ib, Db, vb);
            GAS f32x4* xw = (GAS f32x4*)xr_row(a, m0) + lane;
#pragma unroll
            for (int j = 0; j < 4; ++j) xw[64 * j] = va[j];
            if (two) { GAS f32x4* xw1 = (GAS f32x4*)xr_row(a, m1) + lane;
#pragma unroll
                for (int j = 0; j < 4; ++j) xw1[64 * j] = vb[j]; }
        }
#pragma unroll
        for (int rr = 0; rr < 2; ++rr) {
            if (rr == 1 && !two) break;
            const int m = rr ? m1 : m0; const int s = mods_of_tok(m);
            float ss = 0.f;
#pragma unroll
            for (int j = 0; j < 4; ++j) { const f32x4 t = rr ? vb[j] : va[j]; ss += (t.x * t.x + t.y * t.y) + (t.z * t.z + t.w * t.w); }
            const float rstd = 1.0f / sqrtf(wave_sum(ss) * (1.f / 1024.f) + 1e-6f);
            GAS u32x2* o8 = (GAS u32x2*)(HN + (size_t)m * 1024) + lane;
#pragma unroll
            for (int j = 0; j < 4; ++j) {
                const int k = 4 * lane + 256 * j;
                const f32x4 g = *(const f32x4*)(ng + k), sh = *(const LAS f32x4*)(mvl + s * 2048 + k), sc = *(const LAS f32x4*)(mvl + s * 2048 + 1024 + k);
                const f32x4 h = (rr ? vb[j] : va[j]) * rstd * g * (sc + 1.0f) + sh;
                u32x2 w; w.x = pk2(h.x, h.y); w.y = pk2(h.z, h.w); o8[64 * j] = w;
            }
        }
    }
    __syncthreads();
}

__device__ __forceinline__ void ph_route(const Args& a, int l, int nrows, LAS unsigned char* lds, int vcu, int G, int wave_sg) {
    const int tid = phase_tid(), lane = tid & 63, wave = __builtin_amdgcn_readfirstlane(tid >> 6);
    const int gw = vcu * NWAVES + wave, NGW = G * NWAVES;
    const GAS float* modv = (const GAS float*)(a.ws + WS_TAB + TAB_MODV);
    LAS float* mvl = (LAS float*)lds;
    LAS float* acf = (LAS float*)(lds + 40960);
    LAS float* p2 = (LAS float*)(lds + 61440);
    LAS float* part = (LAS float*)(lds + 63488);
    const float* ng = a.in[I_N2G] + l * 1024;
    for (int i = tid; i < 5 * 2048; i += 512) mvl[i] = modv[(size_t)(l * 5 + i / 2048) * 6144 + 3072 + (i % 2048)];
    __syncthreads();
    for (int i = tid; i < 5 * 1024; i += 512) acf[i] = ng[i & 1023] * (1.f + mvl[(i >> 10) * 2048 + 1024 + (i & 1023)]);
    {
        const int e = lane & 31, kp = lane >> 5;
        float acc[5];
#pragma unroll
        for (int s = 0; s < 5; ++s) acc[s] = 0.f;
        for (int k0 = wave * 128 + kp; k0 < wave * 128 + 128; k0 += 16) {
            float rwv[8];
#pragma unroll
            for (int u = 0; u < 8; ++u) rwv[u] = a.in[I_RW][(size_t)(k0 + 2 * u) * NE + e];
#pragma unroll
            for (int u = 0; u < 8; ++u)
#pragma unroll
                for (int s = 0; s < 5; ++s) acc[s] += mvl[s * 2048 + k0 + 2 * u] * rwv[u];
        }
#pragma unroll
        for (int s = 0; s < 5; ++s) { acc[s] += __shfl_xor(acc[s], 32); if (lane < 32) part[wave * 160 + s * 32 + e] = acc[s]; }
    }
    __syncthreads();
    if (tid < 160) { float v = 0.f;
#pragma unroll
        for (int w = 0; w < 8; ++w) v += part[w * 160 + tid];
        p2[320 + tid] = v; }
    __syncthreads();
    bf16* HN = (bf16*)(a.ws + WS_HN);
    for (int m = gw; m < nrows; m += NGW) {
        const int s = mods_of_tok(m);
        const GAS f32x4* xr = (const GAS f32x4*)xr_row(a, m) + lane;
        f32x4 v[4]; float ss = 0.f;
#pragma unroll
        for (int j = 0; j < 4; ++j) { v[j] = xr[64 * j]; ss += (v[j].x * v[j].x + v[j].y * v[j].y) + (v[j].z * v[j].z + v[j].w * v[j].w); }
        const float rstd = 1.0f / sqrtf(wave_sum(ss) * (1.f / 1024.f) + 1e-6f);
        GAS u32x2* o8 = (GAS u32x2*)(HN + (size_t)m * 1024) + lane;
#pragma unroll
        for (int j = 0; j < 4; ++j) {
            const int k = 4 * lane + 256 * j;
            const f32x4 ac = *(const LAS f32x4*)(acf + s * 1024 + k), sh = *(const LAS f32x4*)(mvl + s * 2048 + k);
            const f32x4 h = v[j] * rstd * ac + sh;
            u32x2 w; w.x = pk2(h.x, h.y); w.y = pk2(h.z, h.w); o8[64 * j] = w;
        }
    }
    int* cnt = (int*)(a.ws + WS_CTL) + CW_CNT + l * NE;
    int* eid = (int*)(a.ws + WS_MISC + MISC_EID); float* gwp = (float*)(a.ws + WS_MISC + MISC_GW); int* posidx = (int*)(a.ws + WS_MISC + MISC_POSIDX); int* lists = (int*)(a.ws + WS_MISC + MISC_LISTS);
    __syncthreads();
    {
        const int kq = wave & 3, half = wave >> 2;
        int lane2 = tid & 63; asm volatile("" : "+v"(lane2));
        const int tok = lane2 & 31, eh = lane2 >> 5;
        LAS float* wst = (LAS float*)(lds + wave * 2048);
        const int wrow = lane2 >> 3, wcol = 4 * (lane2 & 7);
        LAS unsigned* meet = (LAS unsigned*)(lds + LDSCTL_OFF + 2048) + half;
#pragma unroll 1
        for (int tb = vcu * 2 + half; tb < nrows / 32; tb += G * 2) {
            const int m = tb * 32 + tok, s = mods_of_tok(tb * 32);
            const GAS f32x4* xr = (const GAS f32x4*)xr_row(a, m) + kq * 64;
            const float* rwq = a.in[I_RW] + (size_t)(kq * 256) * NE;
            float lg[16]; float ss = 0.f;
#pragma unroll
            for (int e = 0; e < 16; ++e) lg[e] = 0.f;
            f32x4 wr[2], xn[4];
#pragma unroll
            for (int u = 0; u < 2; ++u) wr[u] = *(const f32x4*)(rwq + (size_t)(wrow + 8 * u) * NE + wcol);
#pragma unroll
            for (int u = 0; u < 4; ++u) xn[u] = xr[u];
#pragma unroll 1
            for (int j0 = 0; j0 < 64; j0 += 4) {
#pragma unroll
                for (int u = 0; u < 2; ++u) *(LAS f32x4*)(wst + (wrow + 8 * u) * NE + wcol) = wr[u];
                f32x4 xc[4];
#pragma unroll
                for (int u = 0; u < 4; ++u) xc[u] = xn[u];
                if (j0 + 4 < 64) {
#pragma unroll
                    for (int u = 0; u < 2; ++u) wr[u] = *(const f32x4*)(rwq + (size_t)(4 * (j0 + 4) + wrow + 8 * u) * NE + wcol);
#pragma unroll
                    for (int u = 0; u < 4; ++u) xn[u] = xr[j0 + 4 + u];
                }
#pragma unroll
                for (int u = 0; u < 4; ++u) {
                    const f32x4 x = xc[u];
                    const f32x4 ac = *(const LAS f32x4*)(acf + s * 1024 + kq * 256 + 4 * (j0 + u));
                    ss += (x.x * x.x + x.y * x.y) + (x.z * x.z + x.w * x.w);
#pragma unroll
                    for (int i = 0; i < 4; ++i) {
                        const float t = x[i] * ac[i];
                        const LAS f32x4* wrp = (const LAS f32x4*)(wst + (4 * u + i) * NE + 16 * eh);
#pragma unroll
                        for (int e4 = 0; e4 < 4; ++e4) { const f32x4 w4 = wrp[e4]; lg[4 * e4] += t * w4.x; lg[4 * e4 + 1] += t * w4.y; lg[4 * e4 + 2] += t * w4.z; lg[4 * e4 + 3] += t * w4.w; }
                    }
                }
                asm volatile("s_waitcnt lgkmcnt(0)" ::: "memory");
            }
            LAS float* pp = part + (wave * 64 + lane2) * 17;
#pragma unroll
            for (int e = 0; e < 16; ++e) pp[e] = lg[e];
            pp[16] = ss;
            asm volatile("s_waitcnt lgkmcnt(0)" ::: "memory");
            unsigned tgt = 0;
            if (lane2 == 0) { tgt = (__hip_atomic_fetch_add(meet, 1u, __ATOMIC_RELAXED, __HIP_MEMORY_SCOPE_WORKGROUP) & ~3u) + 4u; }
            tgt = __builtin_amdgcn_readfirstlane(tgt);
            while (__hip_atomic_load(meet, __ATOMIC_RELAXED, __HIP_MEMORY_SCOPE_WORKGROUP) < tgt) __builtin_amdgcn_s_sleep(1);
            asm volatile("" ::: "memory");
            if (kq == 0) {
                float sst = 0.f;
#pragma unroll
                for (int e = 0; e < 16; ++e) lg[e] = 0.f;
#pragma unroll
                for (int q4 = 0; q4 < 4; ++q4) {
                    const LAS float* qp = part + ((half * 4 + q4) * 64 + lane2) * 17;
#pragma unroll
                    for (int e = 0; e < 16; ++e) lg[e] += qp[e];
                    sst += qp[16];
                }
                const float rstd = 1.0f / sqrtf(sst * (1.f / 1024.f) + 1e-6f);
                float sc[16], sel[16];
#pragma unroll
                for (int e = 0; e < 16; ++e) { sc[e] = 1.f / (1.f + expf(-(rstd * lg[e] + p2[320 + s * 32 + 16 * eh + e]))); sel[e] = sc[e] + a.in[I_RB][16 * eh + e]; }
                int bg = 0; float bgs = -INFINITY;
#pragma unroll
                for (int g = 0; g < 4; ++g) {
                    float ta = sel[4 * g], tb2 = -INFINITY;
#pragma unroll
                    for (int i = 1; i < 4; ++i) { const float t = sel[4 * g + i]; if (t > ta) { tb2 = ta; ta = t; } else if (t > tb2) tb2 = t; }
                    const float gs = ta + tb2;
                    if (gs > bgs) { bgs = gs; bg = g; }
                }
                const float obgs = __shfl_xor(bgs, 32);
                const bool win = eh == 0 ? (bgs >= obgs) : (bgs > obgs);
                float s4[4], c4[4];
#pragma unroll
                for (int i = 0; i < 4; ++i) { s4[i] = 0.f; c4[i] = 0.f; }
#pragma unroll
                for (int g = 0; g < 4; ++g)
#pragma unroll
                    for (int i = 0; i < 4; ++i) { s4[i] = (bg == g) ? sel[4 * g + i] : s4[i]; c4[i] = (bg == g) ? sc[4 * g + i] : c4[i]; }
                int i0 = 0, i1 = -1; float fa = s4[0], fb = -INFINITY;
#pragma unroll
                for (int i = 1; i < 4; ++i) { const float t = s4[i]; if (t > fa) { fb = fa; i1 = i0; fa = t; i0 = i; } else if (t > fb) { fb = t; i1 = i; } }
                const float g0 = i0 == 0 ? c4[0] : i0 == 1 ? c4[1] : i0 == 2 ? c4[2] : c4[3];
                const float g1 = i1 == 0 ? c4[0] : i1 == 1 ? c4[1] : i1 == 2 ? c4[2] : c4[3];
                if (win) {
                    const int e0 = (4 * eh + bg) * 4 + i0, e1 = (4 * eh + bg) * 4 + i1;
                    const float inv = 1.f / (g0 + g1);
                    eid[m * 2] = e0; eid[m * 2 + 1] = e1;
                    gwp[m * 2] = g0 * inv; gwp[m * 2 + 1] = g1 * inv;
                    const int ix0 = atomicAdd(&cnt[e0], 1), ix1 = atomicAdd(&cnt[e1], 1);
                    posidx[m * 2] = ix0; posidx[m * 2 + 1] = ix1;
                    lists[(size_t)e0 * LISTCAP + ix0] = m; lists[(size_t)e1 * LISTCAP + ix1] = m;
                }
            }
            asm volatile("s_waitcnt lgkmcnt(0)" ::: "memory");
            if (lane2 == 0) { tgt = (__hip_atomic_fetch_add(meet, 1u, __ATOMIC_RELAXED, __HIP_MEMORY_SCOPE_WORKGROUP) & ~3u) + 4u; }
            tgt = __builtin_amdgcn_readfirstlane(tgt);
            while (__hip_atomic_load(meet, __ATOMIC_RELAXED, __HIP_MEMORY_SCOPE_WORKGROUP) < tgt) __builtin_amdgcn_s_sleep(1);
            asm volatile("" ::: "memory");
        }
    }
    __syncthreads();
    {
        int lane3 = tid & 63; asm volatile("" : "+v"(lane3));
        LAS float* scr = (LAS float*)(lds + 49152 + wave * 8704);
        bf16* WGU = (bf16*)(a.ws + WS_WGU); bf16* WD = (bf16*)(a.ws + WS_WD);
        for (int it = gw; it < NE * 768; it += NGW) {
            const int e = it / 768, r = it % 768;
            if (r < 512) {
                const int up = r >> 8, item = r & 255, n0 = 32 * (item & 15);
                const float* W = a.in[up ? I_WU : I_WG] + (size_t)(l * NE + e) * 1024 * FF;
                transpose_item(W, 1024, FF, WGU + (size_t)e * 1024 * 1024, (n0 >> 7) * 256 + (n0 & 127) + up * 128 - n0, scr, item, lane3);
            } else {
                transpose_item(a.in[I_WD] + (size_t)(l * NE + e) * FF * 1024, FF, 1024, WD + (size_t)e * 1024 * FF, 0, scr, r - 512, lane3);
            }
        }
    }
    __syncthreads();
}

__device__ __forceinline__ void ph_final(const Args& a, LAS unsigned char* lds, int vcu, int G, int wave_sg) {
    const int tid = phase_tid(), lane = tid & 63, wave = __builtin_amdgcn_readfirstlane(tid >> 6);
    const int gw = vcu * NWAVES + wave, NGW = G * NWAVES;
    for (int m0 = gw; m0 < NLAT; m0 += 2 * NGW) {
        const int m1 = m0 + NGW; const bool two = m1 < NLAT; const int m1c = two ? m1 : m0;
        CombIdx Ia, Ib; comb_idx(a, m0, Ia); comb_idx(a, m1c, Ib);
        CombDat Da, Db; comb_dat(a, m0, lane, lds, Ia, Da); comb_dat(a, m1c, lane, lds, Ib, Db);
        f32x4 va[4], vb[4];
        comb_apply(a, 1, m0, lane, Ia, Da, va); comb_apply(a, 1, m1c, lane, Ib, Db, vb);
#pragma unroll
        for (int rr = 0; rr < 2; ++rr) {
            if (rr == 1 && !two) break;
            const int m = rr ? m1 : m0;
            float ss = 0.f;
#pragma unroll
            for (int j = 0; j < 4; ++j) { const f32x4 t = rr ? vb[j] : va[j]; ss += (t.x * t.x + t.y * t.y) + (t.z * t.z + t.w * t.w); }
            const float rstd = 1.0f / sqrtf(wave_sum(ss) * (1.f / 1024.f) + 1e-6f);
            GAS f32x4* xo = (GAS f32x4*)(a.out + (size_t)m * 1024) + lane;
#pragma unroll
            for (int j = 0; j < 4; ++j) xo[64 * j] = (rr ? vb[j] : va[j]) * rstd * *(const f32x4*)(a.in[I_FING] + 4 * lane + 256 * j);
        }
    }
}

__global__ void __launch_bounds__(NWAVES * 64, 2) mk_fwd(Args args) {
    extern __shared__ __attribute__((aligned(16))) unsigned char lds_raw[];
    LAS unsigned char* lds = (LAS unsigned char*)lds_raw;
    volatile LAS unsigned* MISC = (volatile LAS unsigned*)(lds + MISC_OFF);
    const int tid = threadIdx.x;
    const int wave_sg = __builtin_amdgcn_readfirstlane(tid >> 6);
    const int G = gridDim.x; const int bx = blockIdx.x; const int vcu = (G % 8 == 0) ? (bx % 8) * (G / 8) + bx / 8 : bx;
    for (int u = tid; u < (LDS_BYTES - LDSCTL_OFF) / 4; u += NWAVES * 64) ((LAS unsigned*)(lds + LDSCTL_OFF))[u] = 0u;
    __syncthreads();
    unsigned char* ws = args.ws;
    XcdBarrier bar = xcd_barrier_post((unsigned*)(ws + WS_CTL) + CW_BAR + args.li * XCD_BAR_WORDS, MISC + 8);
    const int lo = args.ph_lo, hi = args.ph_hi;
#define IN(k) (lo <= (k) && (k) < hi)
#define SEAM(k) do { if (IN(k) && (k) + 1 < hi) xcd_barrier(bar, wave_sg); } while (0)
    if (IN(0)) { ph_prologue(args, lds, vcu, G, wave_sg); } SEAM(0);
    for (int l = 0; l < 2; ++l) {
        const int pb = 16 * l;
        Args al = args; { unsigned char* w_ = al.ws; asm volatile("" : "+s"(w_)); al.ws = w_; }
        unsigned char* ws = al.ws;
        const int nrows = (l == 0) ? NTOK : NLAT;
        if (IN(pb + 1)) { ph_rowprep(al, l, lds, vcu, G, wave_sg); } SEAM(pb + 1);
        if (IN(pb + 2)) {
            pg8::Gemm g{(const bf16*)(ws + WS_HN), (const bf16*)(ws + WS_WIN) + (size_t)l * INW * 1024, NTOK, INW, 1024};
            pg8::StaticOrder S; S.init(NTOK, INW, G, (int)blockIdx.x);
            pg8::EpiBf16<0> E{(bf16*)(ws + WS_Z), INW, nullptr, 0, 0, 1.f};
            pg8::gemm_phase<pg8::EpiBf16<0>, pg8::StaticOrder, true, true>(lds, g, S, E, wave_sg);
        } SEAM(pb + 2);
        if (IN(pb + 3)) { ph_prep(al, l, vcu, G, wave_sg); } SEAM(pb + 3);
        if (IN(pb + 4)) { ph_la1(al, l, lds, G, wave_sg); } SEAM(pb + 4);
        if (IN(pb + 5)) { ph_la_scan(al, vcu, G, wave_sg); } SEAM(pb + 5);
        if (IN(pb + 6)) { ph_attn(al, l, lds, G, wave_sg); ph_la3(al, l, lds, G, wave_sg); } SEAM(pb + 6);
        if (IN(pb + 7)) {
            pg8::Gemm g{(const bf16*)(ws + WS_HN), (const bf16*)(ws + WS_WOUT) + (size_t)l * 1024 * 1024, nrows, 1024, 1024};
            pg8::StaticOrder S; S.init(nrows, 1024, G, (int)blockIdx.x);
            float* xrc = (float*)(ws + WS_XRC);
            EpiRes E{l == 0 ? args.in[I_X] : args.out, l == 0 ? args.in[I_CTX] : xrc, args.out, xrc, (const float*)(ws + WS_TAB + TAB_MODV) + (size_t)(l * 5) * 6144 + 2048};
            pg8::gemm_phase<EpiRes, pg8::StaticOrder, true, true>(lds, g, S, E, wave_sg);
        } SEAM(pb + 7);
        if (IN(pb + 8)) { ph_route(al, l, nrows, lds, vcu, G, wave_sg); } SEAM(pb + 8);
        if (IN(pb + 10)) {
            moe_block_prefix(al, l, lds, phase_tid());
            volatile LAS int* pbt = (volatile LAS int*)(lds + LDS_PB_OFF);
            pg8::Gemm g{(const bf16*)(ws + WS_HN), (const bf16*)(ws + WS_WGU), NTOK, NE * 1024, 1024};
            MoeOrder S{pbt, G, (int)blockIdx.x, pbt[NE] * 4, (const int*)(ws + WS_MISC + MISC_LISTS)};
            EpiGateUp E{(bf16*)(ws + WS_ACT)};
            pg8::gemm_phase<EpiGateUp, MoeOrder, true, true, true>(lds, g, S, E, wave_sg);
        } SEAM(pb + 10);
        if (IN(pb + 11)) {
            volatile LAS int* pbt = (volatile LAS int*)(lds + LDS_PB_OFF);
            pg8::Gemm g{(const bf16*)(ws + WS_ACT), (const bf16*)(ws + WS_WD), RMAX, NE * 1024, FF};
            MoeOrder S{pbt, G, (int)blockIdx.x, pbt[NE] * 4, (const int*)(ws + WS_MISC + MISC_LISTS)};
            pg8::EpiBf16<0> E{(bf16*)(ws + WS_XS), 1024, nullptr, 1024, 0, 1.f};
            pg8::gemm_phase<pg8::EpiBf16<0>, MoeOrder, true, true>(lds, g, S, E, wave_sg);
        } SEAM(pb + 11);
    }
    if (IN(32)) { ph_final(args, lds, vcu, G, wave_sg); }
#undef IN
#undef SEAM
}
extern "C" void kernel_launch(void* const* d_in, const int* in_sizes, int n_in, void* d_out, int out_size, void* d_ws, size_t ws_size, hipStream_t stream) {
    static int grid = 0;
    if (grid == 0) {
        int dev = 0, cus = 0;
        if (hipGetDevice(&dev) != hipSuccess || hipDeviceGetAttribute(&cus, hipDeviceAttributeMultiprocessorCount, dev) != hipSuccess) { grid = -1; return; }
        if (hipFuncSetAttribute((const void*)mk_fwd, hipFuncAttributeMaxDynamicSharedMemorySize, LDS_BYTES) != hipSuccess) { grid = -1; return; }
        (void)hipGetLastError();
        grid = cus;
    }
    if (grid < 0 || ws_size < 440 * MiB) return;
    (void)hipMemsetAsync((char*)d_ws + WS_CTL, 0, CTL_ZERO_BYTES, stream);
    Args a{};
    for (int i = 0; i < 24; ++i) a.in[i] = (const float*)d_in[i];
    a.out = (float*)d_out; a.ws = (unsigned char*)d_ws;
    a.ph_lo = 0; a.ph_hi = 33; a.li = 0;
    hipLaunchKernelGGL(mk_fwd, dim3(grid), dim3(NWAVES * 64), LDS_BYTES, stream, a);
}
```

```cpp
#include <hip/hip_runtime.h>
#include <cstdio>
#include <cstdint>
#include <math.h>

#define DM 1024
#define NB 4
#define SEQ 8192
#define CTX 256
#define NLAT (NB * SEQ)
#define NCTX (NB * CTX)
#define NTOK (NLAT + NCTX)
#define RB (SEQ + CTX)
#define INW 3584
#define NE 32
#define FF 512
#define RMAX 75776
__device__ __forceinline__ int phase_tid_(int wave_sg) { int w = wave_sg; asm volatile("" : "+s"(w));
    int t = (w << 6) | (int)__builtin_amdgcn_mbcnt_hi(~0u, __builtin_amdgcn_mbcnt_lo(~0u, 0u)); asm volatile("" : "+v"(t)); return t; }
#define phase_tid() phase_tid_(wave_sg)
namespace pg8 {
#define PG8_LAS __attribute__((address_space(3)))
typedef unsigned short bf16_t;
typedef short bf16x8 __attribute__((ext_vector_type(8)));
typedef float f32x4 __attribute__((ext_vector_type(4)));
typedef unsigned u32x4 __attribute__((ext_vector_type(4)));
constexpr int BM = 256, BK = 64, HALF = 128, HTB = HALF * BK * 2  , STAGE_BYTES = 8 * HTB, NXCD = 8, WGM = 8;

__host__ __device__ __forceinline__ int lds_byte(int r, int c) { const int st = (r >> 4) * 2 + (c >> 5), rr = r & 15, cc = c & 31, ob = rr * 64 + cc * 2; return st * 1024 + (ob ^ (((ob >> 9) & 1) << 5)); }
__host__ __device__ __forceinline__ void stage_rc(int b, int& R, int& C) { const int st = b / 1024, sb = b % 1024, swz = sb ^ (((sb >> 9) & 1) << 5); R = (st >> 1) * 16 + swz / 64; C = (st & 1) * 32 + (swz % 64) / 2; }
__host__ __device__ __forceinline__ int perm32(int rho) { const int n = rho >> 4, i = rho & 15; return 8 * (i >> 2) + 4 * n + (i & 3); }

struct Unit { int pm, pn; };
struct Gemm { const bf16_t* A; const bf16_t* Bt; int M, N, K; };

struct StaticOrder {
    int nM, nN, nwg, G, c;
    __host__ __device__ void init(int M, int N, int G_, int c_) { nM = M / BM; nN = N / BM; nwg = nM * nN; G = G_; c = c_; }
    __host__ __device__ bool next(int i, Unit& u) const {
        const long L = (long)i * G + c; if (L >= nwg) return false;
        int wgid = (int)L; { const int q = nwg / NXCD, r = nwg % NXCD, xcd = wgid % NXCD, off = wgid / NXCD; wgid = (xcd < r ? xcd * (q + 1) : r * (q + 1) + (xcd - r) * q) + off; }
        const int nig = WGM * nN, gid = wgid / nig, fm = gid * WGM, gsz = (nM - fm) < WGM ? (nM - fm) : WGM;
        u.pm = fm + ((wgid % nig) % gsz); u.pn = (wgid % nig) / gsz; return true;
    }
    __device__ __forceinline__ void a_ready(const Unit&) const {}
    __device__ __forceinline__ void done(const Unit&) const {}
};

__device__ __forceinline__ unsigned cvt_pk_bf16(float lo, float hi) { unsigned r; asm volatile("v_cvt_pk_bf16_f32 %0, %1, %2" : "=v"(r) : "v"(lo), "v"(hi)); return r; }
typedef float f32x2 __attribute__((ext_vector_type(2)));
__device__ __forceinline__ f32x2 gelu_pk(f32x2 v) {
    const f32x2 av = __builtin_elementwise_abs(v), d = av * 0.2316418882f + 1.0f;
    f32x2 t; t.x = __builtin_amdgcn_rcpf(d.x); t.y = __builtin_amdgcn_rcpf(d.y);
    f32x2 q = t * 0.5307027145f + (-0.7265760135f); q = q * t + 0.7107068705f; q = q * t + (-0.142248368f); q = q * t + 0.127414796f; q = q * t;
    const f32x2 s = (v * v) * (-0.72134752044f);
    f32x2 e; e.x = __builtin_amdgcn_exp2f(s.x); e.y = __builtin_amdgcn_exp2f(s.y);
    const f32x2 m = v * (q * e), r = v - m;
    f32x2 o; o.x = v.x < 0.f ? m.x : r.x; o.y = v.y < 0.f ? m.y : r.y; return o;
}

template <int ACT  > struct EpiBf16 {
    static constexpr bool PERM = true, AFTER_DRAIN = false; static_assert(ACT == 0 || ACT == 1, "EpiBf16: ACT is 0 (none) or 1 (gelu_pk)");
    bf16_t* O; int ldc; const float* bias; int split_cols; size_t split_stride; float scale0;
    __device__ __forceinline__ void operator()(const f32x4 (&acc)[2][2][4][2], const Unit& u, int wr, int wc, int fr, int fq) const {
        const int row0 = u.pm * BM + wr * 64 + fr; int colt = u.pn * BM; bf16_t* base = O;
        float sc = 1.f; if (split_cols) { const int t = colt / split_cols; base += (size_t)t * split_stride; colt -= t * split_cols; if (t == 0) sc = scale0; }
        const int col0 = colt + wc * 32 + 8 * fq, bcol0 = u.pn * BM + wc * 32 + 8 * fq;
        f32x4 bv[2][2];
#pragma unroll
        for (int bj = 0; bj < 2; ++bj)
#pragma unroll
            for (int n = 0; n < 2; ++n) bv[bj][n] = bias ? *(const f32x4*)(bias + bcol0 + bj * HALF + 4 * n) : (f32x4){0.f, 0.f, 0.f, 0.f};
#pragma unroll
        for (int ai = 0; ai < 2; ++ai)
#pragma unroll
            for (int m = 0; m < 4; ++m) { bf16_t* rowp = base + (size_t)(row0 + ai * HALF + m * 16) * ldc + col0;
#pragma unroll
                for (int bj = 0; bj < 2; ++bj) { f32x4 v0 = acc[ai][bj][m][0] + bv[bj][0], v1 = acc[ai][bj][m][1] + bv[bj][1];
                    if (ACT == 1) { f32x2 a = gelu_pk((f32x2){v0[0], v0[1]}), b = gelu_pk((f32x2){v0[2], v0[3]}), c = gelu_pk((f32x2){v1[0], v1[1]}), d = gelu_pk((f32x2){v1[2], v1[3]});
                        v0 = (f32x4){a.x, a.y, b.x, b.y}; v1 = (f32x4){c.x, c.y, d.x, d.y}; }
                    v0 = v0 * sc; v1 = v1 * sc; u32x4 w; w.x = cvt_pk_bf16(v0[0], v0[1]); w.y = cvt_pk_bf16(v0[2], v0[3]); w.z = cvt_pk_bf16(v1[0], v1[1]); w.w = cvt_pk_bf16(v1[2], v1[3]);
                    *(__attribute__((address_space(1))) u32x4*)(rowp + bj * HALF) = w; } }
    }
};

template <class Epi, class Sched, bool ALIGN_EPI = false, bool SP2 = false, bool GATHER = false>
__device__ __forceinline__ void gemm_phase(PG8_LAS unsigned char* lds, const Gemm g, const Sched& S, const Epi& E, int wave_sg) {
    const int tid = phase_tid(), wid = __builtin_amdgcn_readfirstlane(tid >> 6), lane = tid & 63, wr = wid >> 2, wc = wid & 3, fr = lane & 15, fq = lane >> 4;
    const int K = g.K, nt = K / BK;
    unsigned voffA[2], voffB[2];
#pragma unroll
    for (int i = 0; i < 2; ++i) { int R, C; stage_rc(tid * 16 + i * 8192, R, C); const int Rb = Epi::PERM ? ((R & ~31) + perm32(R & 31)) : R;
        voffA[i] = (unsigned)(R * K + C) * 2u; voffB[i] = (unsigned)(Rb * K + C) * 2u; }
    const size_t kstep = (size_t)(BK * 2);
    const size_t hstep = (size_t)HALF * K * 2;
    const size_t tstep = 2 * hstep;
    const unsigned ldsw = (unsigned)wid * 1024u;
    const int aoff = lds_byte(wr * 64 + fr, fq * 8), boff = lds_byte(wc * 32 + fr, fq * 8);
#define PG8_SA(b, h) (((b) * 2 + (h)) * HTB)
#define PG8_SB(b, h) ((4 + (b) * 2 + (h)) * HTB)
#define PG8_STAGE(bufoff, gbase, voff) do { _Pragma("unroll") for (int _i = 0; _i < 2; ++_i) \
        __builtin_amdgcn_global_load_lds((const unsigned*)((const char*)(gbase) + (voff)[_i]), (PG8_LAS unsigned*)(lds + (bufoff) + ldsw + _i * 8192), 16, 0, 0); } while (0)
#define PG8_STAGE_A(bufoff, aptr, kb, h, nx) do { if constexpr (GATHER) { _Pragma("unroll") for (int _i = 0; _i < 2; ++_i) \
        __builtin_amdgcn_global_load_lds((const unsigned*)(gA0 + (kb) + gC[h][_i]), (PG8_LAS unsigned*)(lds + (bufoff) + ldsw + _i * 8192), 16, 0, 0); } \
    else { PG8_STAGE(bufoff, (aptr) + ((h) ? hstep : 0), voffA); } } while (0)
#define PG8_GOFF(dst, unit) do { _Pragma("unroll") for (int _h = 0; _h < 2; ++_h) _Pragma("unroll") for (int _i = 0; _i < 2; ++_i) { int R_, C_; stage_rc(tid * 16 + _i * 8192, R_, C_); \
        dst[_h][_i] = (unsigned)(((size_t)S.arow(unit, _h * HALF + R_) * K + C_) * 2u); } } while (0)
#define PG8_LDA(dst, b, h) do { _Pragma("unroll") for (int m = 0; m < 4; ++m) _Pragma("unroll") for (int k = 0; k < 2; ++k) dst[m][k] = *(const PG8_LAS bf16x8*)(lds + PG8_SA(b, h) + aoff + m * 2048 + k * 1024); } while (0)
#define PG8_LDB(dst, b, h) do { _Pragma("unroll") for (int n = 0; n < 2; ++n) _Pragma("unroll") for (int k = 0; k < 2; ++k) dst[n][k] = *(const PG8_LAS bf16x8*)(lds + PG8_SB(b, h) + boff + n * 2048 + k * 1024); } while (0)
#define PG8_MMA(ai, bj, At, Bt) do { __builtin_amdgcn_s_setprio(1); _Pragma("unroll") for (int m = 0; m < 4; ++m) _Pragma("unroll") for (int n = 0; n < 2; ++n) _Pragma("unroll") for (int k = 0; k < 2; ++k) \
        acc[ai][bj][m][n] = __builtin_amdgcn_mfma_f32_16x16x32_bf16(Bt[n][k], At[m][k], acc[ai][bj][m][n], 0, 0, 0); __builtin_amdgcn_s_setprio(0); } while (0)
#define PG8_WAIT_V(n) asm volatile("s_waitcnt vmcnt(" #n ")" ::: "memory")
#define PG8_WAIT_L(n) asm volatile("s_waitcnt lgkmcnt(" #n ")" ::: "memory")
#define PG8_BAR __builtin_amdgcn_s_barrier()
#define PG8_SCHED __builtin_amdgcn_sched_barrier(0)
    Unit cur, nxt; int ui = 0;
    if (!S.next(0, cur)) return;
    const char* gA0 = (const char*)g.A; unsigned gC[2][2] = {{0u, 0u}, {0u, 0u}};
    PG8_LAS u32x4* gNs = (PG8_LAS u32x4*)(lds + 131072 + 4096) + tid;
    if constexpr (GATHER) PG8_GOFF(gC, cur);
    f32x4 acc[2][2][4][2];
#pragma unroll
    for (int a = 0; a < 2; ++a)
#pragma unroll
        for (int b = 0; b < 2; ++b)
#pragma unroll
            for (int m = 0; m < 4; ++m)
#pragma unroll
                for (int n = 0; n < 2; ++n) acc[a][b][m][n] = (f32x4){0.f, 0.f, 0.f, 0.f};
    bf16x8 At[4][2], B0[2][2], B1[2][2];
    const char* cA = (const char*)g.A + (size_t)cur.pm * tstep; const char* cB = (const char*)g.Bt + (size_t)cur.pn * tstep;
    S.a_ready(cur);
    if constexpr (SP2) {
        PG8_STAGE(PG8_SB(0, 0), cB, voffB); PG8_STAGE(PG8_SB(0, 1), cB + hstep, voffB); PG8_STAGE_A(PG8_SA(0, 0), cA, 0, 0, false); PG8_STAGE_A(PG8_SA(0, 1), cA, 0, 1, false);
        if (wr == 1) PG8_BAR;
        PG8_WAIT_V(2); PG8_BAR;
        PG8_STAGE(PG8_SB(1, 0), cB + kstep, voffB); PG8_STAGE_A(PG8_SA(1, 0), cA + kstep, kstep, 0, false); PG8_STAGE(PG8_SB(1, 1), cB + hstep + kstep, voffB);
        PG8_WAIT_V(6); PG8_BAR;
    } else {
        PG8_STAGE(PG8_SB(0, 0), cB, voffB); PG8_STAGE_A(PG8_SA(0, 0), cA, 0, 0, false); PG8_STAGE(PG8_SB(0, 1), cB + hstep, voffB); PG8_STAGE_A(PG8_SA(0, 1), cA, 0, 1, false);
        if (wr == 1) PG8_BAR;
        PG8_WAIT_V(4); PG8_BAR;
        PG8_STAGE(PG8_SB(1, 0), cB + kstep, voffB); PG8_STAGE_A(PG8_SA(1, 0), cA + kstep, kstep, 0, false); PG8_STAGE(PG8_SB(1, 1), cB + hstep + kstep, voffB);
        PG8_WAIT_V(6); PG8_BAR;
    }
    for (;;) {
        const bool has_next = S.next(ui + 1, nxt);
        if constexpr (GATHER) { if (has_next) { unsigned gT[2][2]; PG8_GOFF(gT, nxt); *gNs = (u32x4){gT[0][0], gT[0][1], gT[1][0], gT[1][1]}; } }
        const char* nA = has_next ? (const char*)g.A + (size_t)nxt.pm * tstep : cA; const char* nB = has_next ? (const char*)g.Bt + (size_t)nxt.pn * tstep : cB;
        for (int t = 0; t < nt; t += 2) {
            const bool last = (t == nt - 2);
            const char* a1 = cA + (size_t)(t + 1) * kstep;
            const char* a2 = last ? nA : cA + (size_t)(t + 2) * kstep; const char* b2 = last ? nB : cB + (size_t)(t + 2) * kstep;
            const char* a3 = a2 + kstep; const char* b3 = b2 + kstep;
            const size_t k2 = last ? 0 : (size_t)(t + 2) * kstep; const bool nxu = last && has_next;
            if (last && has_next) S.a_ready(nxt);
            if constexpr (SP2) {
            PG8_LDB(B0, 0, 0); PG8_LDB(B1, 0, 1); PG8_SCHED; PG8_LDA(At, 0, 0); PG8_STAGE_A(PG8_SA(1, 1), a1, (size_t)(t + 1) * kstep, 1, false); if constexpr (GATHER) { if (nxu) { const u32x4 gx_ = *gNs; gC[0][0] = gx_.x; gC[0][1] = gx_.y; gC[1][0] = gx_.z; gC[1][1] = gx_.w; } }
            PG8_WAIT_V(8); PG8_WAIT_L(0); PG8_BAR; PG8_MMA(0, 0, At, B0); PG8_MMA(0, 1, At, B1); PG8_BAR; PG8_SCHED;
            PG8_LDA(At, 0, 1); PG8_STAGE(PG8_SB(0, 0), b2, voffB); PG8_STAGE(PG8_SB(0, 1), b2 + hstep, voffB); PG8_STAGE_A(PG8_SA(0, 0), a2, k2, 0, nxu);
            PG8_WAIT_V(8); PG8_WAIT_L(0); PG8_BAR; PG8_MMA(1, 0, At, B0); PG8_MMA(1, 1, At, B1); PG8_BAR; PG8_SCHED;
            PG8_LDB(B0, 1, 0); PG8_LDB(B1, 1, 1); PG8_SCHED; PG8_LDA(At, 1, 0); PG8_STAGE_A(PG8_SA(0, 1), a2, k2, 1, nxu);
            PG8_WAIT_V(8); PG8_WAIT_L(0); PG8_BAR; PG8_MMA(0, 0, At, B0); PG8_MMA(0, 1, At, B1); PG8_BAR; PG8_SCHED;
            PG8_LDA(At, 1, 1); PG8_STAGE(PG8_SB(1, 0), b3, voffB); PG8_STAGE(PG8_SB(1, 1), b3 + hstep, voffB); PG8_STAGE_A(PG8_SA(1, 0), a3, k2 + kstep, 0, nxu);
            PG8_WAIT_V(8); PG8_WAIT_L(0); PG8_BAR; PG8_MMA(1, 0, At, B0); PG8_MMA(1, 1, At, B1); PG8_BAR; PG8_SCHED;
            } else {
            PG8_LDB(B0, 0, 0); PG8_SCHED; PG8_LDA(At, 0, 0); PG8_STAGE_A(PG8_SA(1, 1), a1, (size_t)(t + 1) * kstep, 1, false); if constexpr (GATHER) { if (nxu) { const u32x4 gx_ = *gNs; gC[0][0] = gx_.x; gC[0][1] = gx_.y; gC[1][0] = gx_.z; gC[1][1] = gx_.w; } }
            PG8_WAIT_L(8); PG8_BAR; PG8_WAIT_L(0); PG8_MMA(0, 0, At, B0); PG8_BAR; PG8_SCHED;
            PG8_LDB(B1, 0, 1); PG8_STAGE(PG8_SB(0, 0), b2, voffB);
            PG8_BAR; PG8_WAIT_L(0); PG8_MMA(0, 1, At, B1); PG8_BAR;
            PG8_LDA(At, 0, 1); PG8_STAGE_A(PG8_SA(0, 0), a2, k2, 0, nxu);
            PG8_BAR; PG8_WAIT_L(0); PG8_MMA(1, 0, At, B0); PG8_BAR; PG8_SCHED;
            PG8_STAGE(PG8_SB(0, 1), b2 + hstep, voffB);
            PG8_WAIT_V(6); PG8_BAR; PG8_MMA(1, 1, At, B1); PG8_BAR;
            PG8_LDB(B0, 1, 0); PG8_SCHED; PG8_LDA(At, 1, 0); PG8_STAGE_A(PG8_SA(0, 1), a2, k2, 1, nxu);
            PG8_WAIT_L(8); PG8_BAR; PG8_WAIT_L(0); PG8_MMA(0, 0, At, B0); PG8_BAR; PG8_SCHED;
            PG8_LDB(B1, 1, 1); PG8_STAGE(PG8_SB(1, 0), b3, voffB);
            PG8_BAR; PG8_WAIT_L(0); PG8_MMA(0, 1, At, B1); PG8_BAR;
            PG8_LDA(At, 1, 1); PG8_STAGE_A(PG8_SA(1, 0), a3, k2 + kstep, 0, nxu);
            PG8_BAR; PG8_WAIT_L(0); PG8_MMA(1, 0, At, B0); PG8_BAR; PG8_SCHED;
            PG8_STAGE(PG8_SB(1, 1), b3 + hstep, voffB);
            PG8_WAIT_V(6); PG8_BAR; PG8_MMA(1, 1, At, B1); PG8_BAR;
            }
        }
        if constexpr (ALIGN_EPI) { if (wr == 0) PG8_BAR; }
        if constexpr (!Epi::AFTER_DRAIN) { E(acc, cur, wr, wc, fr, fq); S.done(cur); }
        if (!has_next) break;
#pragma unroll
        for (int a = 0; a < 2; ++a)
#pragma unroll
            for (int b = 0; b < 2; ++b)
#pragma unroll
                for (int m = 0; m < 4; ++m)
#pragma unroll
                    for (int n = 0; n < 2; ++n) acc[a][b][m][n] = (f32x4){0.f, 0.f, 0.f, 0.f};
        cur = nxt; cA = nA; cB = nB; ++ui;
        if constexpr (ALIGN_EPI) { if (wr == 1) PG8_BAR; }
    }
    PG8_WAIT_V(0);
    if constexpr (!ALIGN_EPI) { if (wr == 0) PG8_BAR; }
    PG8_BAR;
    if constexpr (Epi::AFTER_DRAIN) { E.fused(acc, cur, wr, wc, fr, fq, lds, wid, lane); S.done(cur); }
#undef PG8_SA
#undef PG8_SB
#undef PG8_STAGE
#undef PG8_STAGE_A
#undef PG8_GOFF
#undef PG8_LDA
#undef PG8_LDB
#undef PG8_MMA
#undef PG8_WAIT_V
#undef PG8_WAIT_L
#undef PG8_BAR
#undef PG8_SCHED
}
}
#define GAS __attribute__((address_space(1)))
#define LAS __attribute__((address_space(3)))
typedef unsigned short bf16;
typedef unsigned v4u __attribute__((ext_vector_type(4)));
typedef float f32x4 __attribute__((ext_vector_type(4)));
typedef short bf16x8 __attribute__((ext_vector_type(8)));
typedef GAS unsigned gu32;
typedef GAS unsigned long long gu64;
#define RLX_AGENT __ATOMIC_RELAXED, __HIP_MEMORY_SCOPE_AGENT
#define LDS_WAIT() asm volatile("s_waitcnt lgkmcnt(0)" ::: "memory")
#define VM_WAIT() asm volatile("s_waitcnt vmcnt(0)" ::: "memory")
__device__ __forceinline__ unsigned long long rt() { return __builtin_amdgcn_s_memrealtime(); }
__device__ __forceinline__ unsigned f2bf(float f) { unsigned u = __builtin_bit_cast(unsigned, f); return (u + 0x7fffu + ((u >> 16) & 1u)) >> 16; }
__device__ __forceinline__ unsigned pk2(float lo, float hi) { return f2bf(lo) | (f2bf(hi) << 16); }

#define XB_TMO      128
#define XB_XCNT(j)  (256  + 64 * (j))
#define XB_XSUB(j)  (1280 + 64 * (j))
#define XB_XGEN(j)  (2304 + 64 * (j))
#define XB_TOP      3328
#define XB_TOPGEN   3392
#define XCD_BAR_WORDS 3456
#define XB_SPIN_CAP (1u << 18)

__device__ __forceinline__ unsigned xb_ld(unsigned* p)              { return __hip_atomic_load(p, __ATOMIC_RELAXED, __HIP_MEMORY_SCOPE_AGENT); }
__device__ __forceinline__ unsigned xb_add(unsigned* p, unsigned v) { return __hip_atomic_fetch_add(p, v, __ATOMIC_RELAXED, __HIP_MEMORY_SCOPE_AGENT); }
__device__ __forceinline__ unsigned xb_xcc_id() { return (unsigned)__builtin_amdgcn_s_getreg((3 << 11) | 20) & 0xFu; }
#define XB_SPIN(cond, bar) do { unsigned _sp = 0; while (cond) { __builtin_amdgcn_s_sleep(1); \
    if ((++_sp & 255u) == 0u) { if (xb_ld(&(bar)[XB_TMO])) break; if (_sp > XB_SPIN_CAP) { atomicAdd(&(bar)[XB_TMO], 1u); break; } } } } while (0)

struct XcdBarrier {
    unsigned* bar; unsigned x;
    volatile LAS unsigned* st;
};

__device__ __forceinline__ XcdBarrier xcd_barrier_post(unsigned* bar, volatile LAS unsigned* st) {
    XcdBarrier b; b.bar = bar; b.x = xb_xcc_id(); b.st = st;
    if (threadIdx.x == 0) (void)xb_add(&bar[XB_XCNT(b.x)], 1u);
    return b;
}
__device__ __forceinline__ void xcd_barrier_complete(unsigned* bar, unsigned x, unsigned& nloc, unsigned& nx) {
    const unsigned G = gridDim.x * gridDim.y * gridDim.z;
    unsigned sum, cnt, mine, sp = 0u;
    for (;;) {
        sum = 0u; cnt = 0u; mine = 0u;
#pragma unroll
        for (unsigned j = 0; j < 16; ++j) { const unsigned c = xb_ld(&bar[XB_XCNT(j)]); sum += c; cnt += (c > 0u) ? 1u : 0u; mine = (j == x) ? c : mine; }
        if (sum == G) break;
        __builtin_amdgcn_s_sleep(1);
        if ((++sp & 255u) == 0u) { if (xb_ld(&bar[XB_TMO])) break; if (sp > XB_SPIN_CAP) { atomicAdd(&bar[XB_TMO], 1u); break; } }
    }
    nloc = mine > 0u ? mine : 1u; nx = cnt > 0u ? cnt : 1u;
}

__device__ __forceinline__ void xcd_barrier(const XcdBarrier& b, int wave_sg  ) {
    asm volatile("s_waitcnt vmcnt(0)" ::: "memory");
    __syncthreads();
    if (wave_sg == 0 && __builtin_amdgcn_mbcnt_hi(~0u, __builtin_amdgcn_mbcnt_lo(~0u, 0u)) == 0u) {
        unsigned* bar = b.bar;
        __builtin_amdgcn_s_waitcnt(0);
        unsigned nloc = b.st[0], nx = b.st[1];
        if (nloc == 0u) { xcd_barrier_complete(bar, b.x, nloc, nx); b.st[0] = nloc; b.st[1] = nx; }
        const unsigned old = xb_add(&bar[XB_XSUB(b.x)], 1u);
        const unsigned gen = old / nloc;
        if (old + 1u == (gen + 1u) * nloc) {
            __builtin_amdgcn_fence(__ATOMIC_RELEASE, "agent");
            asm volatile("s_waitcnt vmcnt(0)" ::: "memory");
            const unsigned og = xb_add(&bar[XB_TOP], 1u);
            const unsigned tg = og / nx;
            if (og + 1u == (tg + 1u) * nx) xb_add(&bar[XB_TOPGEN], 1u);
            else XB_SPIN(xb_ld(&bar[XB_TOPGEN]) == tg, bar);
            __builtin_amdgcn_fence(__ATOMIC_ACQUIRE, "agent");
            xb_add(&bar[XB_XGEN(b.x)], 1u);
            asm volatile("s_waitcnt vmcnt(0)" ::: "memory");
        } else {
            XB_SPIN(xb_ld(&bar[XB_XGEN(b.x)]) == gen, bar);
            __builtin_amdgcn_fence(__ATOMIC_ACQUIRE, "agent");
            asm volatile("s_waitcnt vmcnt(0)" ::: "memory");
        }
    }
    __syncthreads();
}
constexpr size_t MiB = 1u << 20;
constexpr size_t WS_CTL = 0, CTL_ZERO_BYTES = 1 * MiB;
constexpr size_t WS_TAB = 1 * MiB;
constexpr size_t WS_WIN = 5 * MiB;
constexpr size_t WS_WOUT = 19 * MiB;
constexpr size_t WS_XRC = 23 * MiB;
constexpr size_t WS_XR16 = 440 * MiB;
constexpr size_t WS_HN = 27 * MiB;
constexpr size_t WS_MISC = 93 * MiB;
constexpr size_t WS_REG = 109 * MiB;
constexpr size_t WS_Z = WS_REG;
constexpr size_t WS_XS = WS_REG;
constexpr size_t WS_ACT = WS_REG + 148 * MiB;
constexpr size_t WS_WGU = WS_REG + 222 * MiB;
constexpr size_t WS_WD = 506 * MiB;
constexpr size_t MISC_LISTS = 7 * MiB; constexpr int LISTCAP = NTOK * 2;
constexpr size_t MISC_EID = 64 * 1024, MISC_GW = 384 * 1024, MISC_POSIDX = 704 * 1024, MISC_POSROW = 1024 * 1024;
constexpr size_t TAB_ROPE_HC = 0, TAB_ROPE_HS = 1 * MiB, TAB_ROPE_DC = 2 * MiB, TAB_ROPE_DS = 2 * MiB + 512 * 1024, TAB_LBV = 3 * MiB, TAB_GAM = 3 * MiB + 4096, TAB_LAM = 3 * MiB + 8192;
constexpr int CW_TMO = 0, CW_CODE = 1, CW_CNT = 64, CW_FILL = 128, CW_KMAX = 320;
constexpr int CW_PRORDY = 960;
constexpr int CW_PREPRDY = 1280;
constexpr int CW_LA1RDY = 1152;
constexpr int CW_SCANRDY = 576;
constexpr int CW_BAR = 4096;
constexpr size_t TAB_RWT = 3 * MiB + 512 * 1024;
constexpr size_t TAB_MODV = 3 * MiB + 16384;
constexpr size_t MISC_MODVP = 2 * MiB;
constexpr int NWAVES = 8;
constexpr int RING_BYTES = 131072, LDSCTL_OFF = RING_BYTES, MISC_OFF = LDSCTL_OFF + 320, LDS_PB_OFF = LDSCTL_OFF + 1024, LDS_BYTES = 147456;

typedef unsigned u32x2 __attribute__((ext_vector_type(2)));
typedef unsigned u32x4 __attribute__((ext_vector_type(4)));
__device__ __forceinline__ float bf2f(unsigned h) { return __uint_as_float(h << 16); }
__device__ __forceinline__ float siluf(float v) { return v / (1.f + __expf(-v)); }
__device__ __forceinline__ float sigmf(float v) { return 1.f / (1.f + __expf(-v)); }
__device__ __forceinline__ float wave_sum(float v) {
#pragma unroll
    for (int o = 32; o > 0; o >>= 1) v += __shfl_xor(v, o);
    return v;
}
__device__ __forceinline__ int tok_of(int b, int r) { return r < SEQ ? b * SEQ + r : NLAT + b * CTX + (r - SEQ); }
__device__ __forceinline__ int mods_of_tok(int m) { return m < NLAT ? m / SEQ : 4; }

struct Args { const float* in[24]; float* out; unsigned char* ws; int ph_lo, ph_hi, li, pad; };
enum { I_X = 0, I_C, I_CTX, I_CCTX, I_WMOD, I_BMOD, I_N1G, I_N2G, I_WIN, I_RETDL, I_RETNG, I_GQG, I_GKG, I_HGLB, I_HGNG, I_DFLAM, I_DFNG, I_WOUT, I_RW, I_RB, I_WG, I_WU, I_WD, I_FING };

template <bool SRC16> struct EpiRes {
    static constexpr bool PERM = true, AFTER_DRAIN = false;
    const float* src_lat; const float* src_ctx; bf16* xr; const float* g;
    __device__ __forceinline__ void operator()(const pg8::f32x4 (&acc)[2][2][4][2], const pg8::Unit& u, int wr, int wc, int fr, int fq) const {
        const bool lat = u.pm < NLAT / 256;
        const int s = lat ? (u.pm >> 5) : 4;
        const int rsrc = lat ? u.pm * 256 : u.pm * 256 - NLAT;
        const float* src = (lat ? src_lat : src_ctx);
        const int col0 = u.pn * 256 + wc * 32 + 8 * fq;
        const float* gv = g + (size_t)s * 6144 + col0;
        pg8::f32x4 gg[2][2];
#pragma unroll
        for (int bj = 0; bj < 2; ++bj)
#pragma unroll
            for (int n = 0; n < 2; ++n) gg[bj][n] = *(const GAS pg8::f32x4*)(gv + bj * 128 + n * 4);
#pragma unroll
        for (int ai = 0; ai < 2; ++ai)
#pragma unroll
            for (int m = 0; m < 4; ++m) {
                const int rl = ai * 128 + wr * 64 + m * 16 + fr;
                bf16* xp = xr + (size_t)(u.pm * 256 + rl) * 1024 + col0;
#pragma unroll
                for (int bj = 0; bj < 2; ++bj) {
                    pg8::f32x4 x0, x1;
                    if (SRC16) { const pg8::u32x4 w = *(const GAS pg8::u32x4*)(xp + bj * 128);
                        x0 = (pg8::f32x4){__uint_as_float(w.x << 16), __uint_as_float(w.x & 0xffff0000u), __uint_as_float(w.y << 16), __uint_as_float(w.y & 0xffff0000u)};
                        x1 = (pg8::f32x4){__uint_as_float(w.z << 16), __uint_as_float(w.z & 0xffff0000u), __uint_as_float(w.w << 16), __uint_as_float(w.w & 0xffff0000u)}; }
                    else { const float* sp = src + (size_t)(rsrc + rl) * 1024 + col0 + bj * 128; x0 = *(const GAS pg8::f32x4*)sp; x1 = *(const GAS pg8::f32x4*)(sp + 4); }
                    const pg8::f32x4 v0 = x0 + gg[bj][0] * acc[ai][bj][m][0], v1 = x1 + gg[bj][1] * acc[ai][bj][m][1];
                    pg8::u32x4 o; o.x = pg8::cvt_pk_bf16(v0[0], v0[1]); o.y = pg8::cvt_pk_bf16(v0[2], v0[3]); o.z = pg8::cvt_pk_bf16(v1[0], v1[1]); o.w = pg8::cvt_pk_bf16(v1[2], v1[3]);
                    *(GAS pg8::u32x4*)(xp + bj * 128) = o;
                }
            }
    }
};

struct EpiGateUp {
    static constexpr bool PERM = true, AFTER_DRAIN = false;
    bf16* O;
    __device__ __forceinline__ void operator()(const pg8::f32x4 (&acc)[2][2][4][2], const pg8::Unit& u, int wr, int wc, int fr, int fq) const {
        const int row0 = u.pm * 256 + wr * 64 + fr, col0 = (u.pn & 3) * 128 + wc * 32 + 8 * fq;
#pragma unroll
        for (int ai = 0; ai < 2; ++ai)
#pragma unroll
            for (int m = 0; m < 4; ++m) {
                float r[8];
#pragma unroll
                for (int n = 0; n < 2; ++n)
#pragma unroll
                    for (int i = 0; i < 4; ++i) { const float g = acc[ai][0][m][n][i], up = acc[ai][1][m][n][i]; r[n * 4 + i] = g * __builtin_amdgcn_rcpf(1.f + __expf(-g)) * up; }
                pg8::u32x4 w; w.x = pg8::cvt_pk_bf16(r[0], r[1]); w.y = pg8::cvt_pk_bf16(r[2], r[3]); w.z = pg8::cvt_pk_bf16(r[4], r[5]); w.w = pg8::cvt_pk_bf16(r[6], r[7]);
                *(GAS pg8::u32x4*)(O + (size_t)(row0 + ai * 128 + m * 16) * 512 + col0) = w;
            }
    }
};
struct MoeOrder {
    const volatile LAS int* pb; int G, c, nunits; const int* lists;
    __device__ __forceinline__ bool next(int i, pg8::Unit& u) const {
        const int L = i * G + c; if (L >= nunits) return false;
        int w = L; { const int q = nunits / 8, r = nunits % 8, x = w % 8, off = w / 8; w = (x < r ? x * (q + 1) : r * (q + 1) + (x - r) * q) + off; }
        const int rb = w >> 2, pn4 = w & 3;
        int e = 0;
#pragma unroll
        for (int j = 1; j < 32; ++j) e += (pb[j] <= rb) ? 1 : 0;
        u.pm = rb; u.pn = e * 4 + pn4; return true;
    }
    __device__ __forceinline__ int arow(const pg8::Unit& u, int rl) const { const int e = u.pn >> 2, idx = (u.pm - pb[e]) * 256 + rl; return idx < pb[64 + e] ? lists[(size_t)e * LISTCAP + idx] : 0; }
    __device__ __forceinline__ void a_ready(const pg8::Unit&) const {}
    __device__ __forceinline__ void done(const pg8::Unit&) const {}
};
typedef float f32x16 __attribute__((ext_vector_type(16)));
typedef __bf16 bf16x2_t __attribute__((ext_vector_type(2)));
typedef float f32x2_t __attribute__((ext_vector_type(2)));
constexpr size_t WS_VGT = WS_REG + 231 * MiB;
constexpr size_t WS_VDT = WS_REG + 240 * MiB;
constexpr size_t MISC_QNG = 4 * MiB, MISC_QND = 5 * MiB;
constexpr int NKEY = RB;
constexpr float LOG2E = 1.4426950408889634f;
constexpr int AT_KSTR = 144, AT_VSTR = 136, AT_KBYTES = 64 * AT_KSTR, AT_VBYTES = 64 * AT_VSTR, AT_BUF = AT_KBYTES + AT_VBYTES;
__device__ __forceinline__ int zrow_of_key(int b, int kap) { return kap < CTX ? NLAT + b * CTX + kap : b * SEQ + (kap - CTX); }
__device__ __forceinline__ unsigned cvtpk(float lo, float hi) { f32x2_t v = {lo, hi}; bf16x2_t r = __builtin_convertvector(v, bf16x2_t); return __builtin_bit_cast(unsigned, r); }
__device__ __forceinline__ float wave_max(float v) {
#pragma unroll
    for (int o = 32; o > 0; o >>= 1) v = fmaxf(v, __shfl_xor(v, o));
    return v;
}

constexpr int PP_STR = 144;
__device__ __forceinline__ void ph_prep(const Args& a, int l, LAS unsigned char* lds, int vcu, int G, int wave_sg) {
    const int tid = phase_tid(), lane = tid & 63, wave = __builtin_amdgcn_readfirstlane(tid >> 6);
    const int gw = vcu * NWAVES + wave, NGW = G * NWAVES;
    bf16* Z = (bf16*)(a.ws + WS_Z);
    const float* HC = (const float*)(a.ws + WS_TAB + TAB_ROPE_HC); const float* HS = (const float*)(a.ws + WS_TAB + TAB_ROPE_HS);
    const float* DC = (const float*)(a.ws + WS_TAB + TAB_ROPE_DC); const float* DS = (const float*)(a.ws + WS_TAB + TAB_ROPE_DS);
    unsigned* kmaxw = (unsigned*)(a.ws + WS_CTL) + CW_KMAX + l * 64;
    GAS float* QNG = (GAS float*)(a.ws + WS_MISC + MISC_QNG); GAS float* QND = (GAS float*)(a.ws + WS_MISC + MISC_QND);
    LAS unsigned char* wl = lds + wave * (64 * PP_STR);
    const int gr = lane >> 3, gc = lane & 7;
    for (int it = gw; it < (NTOK / 64) * 20; it += NGW) {
        const int tb = it / 20, u = it % 20;
        const int m = tb * 64 + lane; const bool lat = tb < NLAT / 64;
        int b, kap, t;
        if (lat) { b = m >> 13; t = m & (SEQ - 1); kap = CTX + t; } else { const int mm = m - NLAT; b = mm >> 8; kap = mm & (CTX - 1); t = 0; }
        int kind, hd, col;
        if (u < 2) { kind = 1; hd = u; col = 1280 + 64 * hd; }
        else if (u < 4) { kind = 2; hd = u - 2; col = 1408 + 64 * hd; }
        else if (u < 8) { kind = 4; hd = u - 4; col = 3072 + 64 * hd; }
        else if (u < 12) { kind = 5; hd = u - 8; col = 3328 + 64 * hd; }
        else if (u < 16) { kind = 6; hd = u - 12; col = 64 * hd; }
        else { kind = 7; hd = u - 16; col = 256 + 64 * hd; }
        GAS unsigned char* zt = (GAS unsigned char*)(Z + (size_t)(tb * 64) * INW + col) + (size_t)gr * (INW * 2) + gc * 16;
        v4u raw[8];
        {
            v4u g_[8];
#pragma unroll
            for (int i = 0; i < 8; ++i) g_[i] = *(const GAS v4u*)(zt + (size_t)(8 * i) * (INW * 2));
#pragma unroll
            for (int i = 0; i < 8; ++i) *(LAS v4u*)(wl + (gr + 8 * i) * PP_STR + gc * 16) = g_[i];
        }
        asm volatile("" ::: "memory");
#pragma unroll
        for (int c = 0; c < 8; ++c) raw[c] = *(const LAS v4u*)(wl + lane * PP_STR + c * 16);
        asm volatile("" ::: "memory");
        if (kind == 2 || kind == 5) {
            GAS bf16* VT = (kind == 2) ? (GAS bf16*)(a.ws + WS_VGT) + (size_t)((b * 2 + hd) * 64) * NKEY : (GAS bf16*)(a.ws + WS_VDT) + (size_t)((b * 4 + hd) * 64) * NKEY;
            const int kap0 = __builtin_amdgcn_readfirstlane(kap);
#pragma unroll
            for (int c = 0; c < 8; ++c)
#pragma unroll
                for (int i = 0; i < 4; ++i) { const unsigned w = raw[c][i];
                    *(LAS unsigned short*)(wl + (c * 8 + i * 2) * PP_STR + lane * 2) = (unsigned short)(w & 0xffffu); *(LAS unsigned short*)(wl + (c * 8 + i * 2 + 1) * PP_STR + lane * 2) = (unsigned short)(w >> 16); }
            asm volatile("" ::: "memory");
#pragma unroll
            for (int i = 0; i < 8; ++i) { const v4u o_ = *(const LAS v4u*)(wl + (gr + 8 * i) * PP_STR + gc * 16);
                *(GAS v4u*)((GAS unsigned char*)VT + ((size_t)(gr + 8 * i) * NKEY + kap0) * 2 + gc * 16) = o_; }
            asm volatile("" ::: "memory");
            continue;
        }
        float x[64];
#pragma unroll
        for (int c = 0; c < 8; ++c)
#pragma unroll
            for (int i = 0; i < 4; ++i) { x[c * 8 + i * 2] = __uint_as_float(raw[c][i] << 16); x[c * 8 + i * 2 + 1] = __uint_as_float(raw[c][i] & 0xffff0000u); }
        if (kind <= 1 || kind >= 6) {
            if (kind <= 1) {
                float ss = 0.f;
#pragma unroll
                for (int d = 0; d < 64; ++d) ss += x[d] * x[d];
                const float rstd = 1.0f / sqrtf(ss * (1.f / 64.f) + 1e-6f);
                const float* g = a.in[kind == 0 ? I_GQG : I_GKG] + l * 64;
#pragma unroll
                for (int d = 0; d < 64; ++d) x[d] = x[d] * rstd * g[d];
            }
            if (lat) {
                const int tr = t & ~63, tc = t & 63;
                const GAS f32x4* cpr = (const GAS f32x4*)(HC + (size_t)tr * 32); const GAS f32x4* spr = (const GAS f32x4*)(HS + (size_t)tr * 32);
                const GAS f32x4* cpc = (const GAS f32x4*)(HC + (size_t)tc * 32); const GAS f32x4* spc = (const GAS f32x4*)(HS + (size_t)tc * 32);
#pragma unroll
                for (int c = 0; c < 8; ++c) { const f32x4 cs = c < 4 ? cpr[c] : cpc[c], sn = c < 4 ? spr[c] : spc[c];
#pragma unroll
                    for (int i = 0; i < 4; ++i) { const float x1 = x[c * 4 + i], x2 = x[c * 4 + i + 32]; x[c * 4 + i] = x1 * cs[i] - x2 * sn[i]; x[c * 4 + i + 32] = x2 * cs[i] + x1 * sn[i]; }
                    if (c == 3) asm volatile("" ::: "memory");     }
            }
            if (kind == 0 || kind == 6) {
                const float sc = (kind == 0) ? 0.125f * LOG2E : 0.125f;
#pragma unroll
                for (int d = 0; d < 64; ++d) x[d] *= sc;
            }
        } else {
            if (lat) {
                const int tr = t & ~63, tc = t & 63;
                const GAS f32x4* cpr = (const GAS f32x4*)(DC + (size_t)tr * 16); const GAS f32x4* spr = (const GAS f32x4*)(DS + (size_t)tr * 16);
                const GAS f32x4* cpc = (const GAS f32x4*)(DC + (size_t)tc * 16); const GAS f32x4* spc = (const GAS f32x4*)(DS + (size_t)tc * 16);
#pragma unroll
                for (int c = 0; c < 4; ++c) { const f32x4 cs = c < 2 ? cpr[c] : cpc[c], sn = c < 2 ? spr[c] : spc[c];
#pragma unroll
                    for (int i = 0; i < 4; ++i)
#pragma unroll
                        for (int mp = 0; mp < 2; ++mp) { const int i1 = 32 * mp + c * 4 + i; const float x1 = x[i1], x2 = x[i1 + 16]; x[i1] = x1 * cs[i] - x2 * sn[i]; x[i1 + 16] = x2 * cs[i] + x1 * sn[i]; } }
            }
            if (kind == 3) {
#pragma unroll
                for (int d = 0; d < 64; ++d) x[d] *= 0.17677669529663687f * LOG2E;
            }
        }
        float n1 = 0.f, n2 = 0.f;
#pragma unroll
        for (int c = 0; c < 8; ++c) {
#pragma unroll
            for (int i = 0; i < 4; ++i) {
                const unsigned w = cvtpk(x[c * 8 + i * 2], x[c * 8 + i * 2 + 1]);
                const float r0 = __uint_as_float(w << 16), r1 = __uint_as_float(w & 0xffff0000u);
                if (c < 4) n1 += r0 * r0 + r1 * r1; else n2 += r0 * r0 + r1 * r1;
                raw[c][i] = w;
            }
        }
#pragma unroll
        for (int c = 0; c < 8; ++c) *(LAS v4u*)(wl + lane * PP_STR + c * 16) = raw[c];
        asm volatile("" ::: "memory");
#pragma unroll
        for (int i = 0; i < 8; ++i) { const v4u o_ = *(const LAS v4u*)(wl + (gr + 8 * i) * PP_STR + gc * 16); *(GAS v4u*)(zt + (size_t)(8 * i) * (INW * 2)) = o_; }
        asm volatile("" ::: "memory");
        if (kind == 1) { const float mx = wave_max(n1 + n2); if (lane == 0) atomicMax(kmaxw + b * 2 + hd, __float_as_uint(mx)); }
        else if (kind == 4) { const float m1 = wave_max(n1), m2 = wave_max(n2); if (lane == 0) { atomicMax(kmaxw + 8 + (b * 4 + hd) * 2, __float_as_uint(m1)); atomicMax(kmaxw + 8 + (b * 4 + hd) * 2 + 1, __float_as_uint(m2)); } }
    }
}

template <bool DIFFQ>
__device__ __forceinline__ void q_prepare(const Args& a, int l, bf16x8 (&qf)[4], bool lat, int t, int hi, float& n1, float& n2) {
    float x[4][8];
#pragma unroll
    for (int ds = 0; ds < 4; ++ds)
#pragma unroll
        for (int j = 0; j < 8; ++j) x[ds][j] = __uint_as_float((unsigned)(unsigned short)qf[ds][j] << 16);
    if (!DIFFQ) {
        float ss = 0.f;
#pragma unroll
        for (int ds = 0; ds < 4; ++ds)
#pragma unroll
            for (int j = 0; j < 8; ++j) ss += x[ds][j] * x[ds][j];
        ss += __shfl_xor(ss, 32);
        const float rstd = 1.0f / sqrtf(ss * (1.f / 64.f) + 1e-6f);
        const float* g = a.in[I_GQG] + l * 64 + 8 * hi;
#pragma unroll
        for (int ds = 0; ds < 4; ++ds) { const f32x4 g0 = *(const GAS f32x4*)(g + 16 * ds), g1 = *(const GAS f32x4*)(g + 16 * ds + 4);
#pragma unroll
            for (int j = 0; j < 4; ++j) { x[ds][j] = x[ds][j] * rstd * g0[j]; x[ds][4 + j] = x[ds][4 + j] * rstd * g1[j]; } }
        if (lat) {
            const GAS float* HC = (const GAS float*)(a.ws + WS_TAB + TAB_ROPE_HC) + (size_t)t * 32 + 8 * hi; const GAS float* HS = (const GAS float*)(a.ws + WS_TAB + TAB_ROPE_HS) + (size_t)t * 32 + 8 * hi;
#pragma unroll
            for (int ds = 0; ds < 2; ++ds) { const f32x4 c0 = *(const GAS f32x4*)(HC + 16 * ds), c1 = *(const GAS f32x4*)(HC + 16 * ds + 4), s0 = *(const GAS f32x4*)(HS + 16 * ds), s1 = *(const GAS f32x4*)(HS + 16 * ds + 4);
#pragma unroll
                for (int j = 0; j < 8; ++j) { const float cs = j < 4 ? c0[j & 3] : c1[j & 3], sn = j < 4 ? s0[j & 3] : s1[j & 3]; const float x1 = x[ds][j], x2 = x[ds + 2][j]; x[ds][j] = x1 * cs - x2 * sn; x[ds + 2][j] = x2 * cs + x1 * sn; } }
        }
#pragma unroll
        for (int ds = 0; ds < 4; ++ds)
#pragma unroll
            for (int j = 0; j < 8; ++j) x[ds][j] *= 0.125f * LOG2E;
    } else {
        if (lat) {
            const GAS float* DC = (const GAS float*)(a.ws + WS_TAB + TAB_ROPE_DC) + (size_t)t * 16 + 8 * hi; const GAS float* DS = (const GAS float*)(a.ws + WS_TAB + TAB_ROPE_DS) + (size_t)t * 16 + 8 * hi;
            const f32x4 c0 = *(const GAS f32x4*)(DC), c1 = *(const GAS f32x4*)(DC + 4), s0 = *(const GAS f32x4*)(DS), s1 = *(const GAS f32x4*)(DS + 4);
#pragma unroll
            for (int mp = 0; mp < 2; ++mp)
#pragma unroll
                for (int j = 0; j < 8; ++j) { const float cs = j < 4 ? c0[j & 3] : c1[j & 3], sn = j < 4 ? s0[j & 3] : s1[j & 3]; const float x1 = x[2 * mp][j], x2 = x[2 * mp + 1][j]; x[2 * mp][j] = x1 * cs - x2 * sn; x[2 * mp + 1][j] = x2 * cs + x1 * sn; }
        }
#pragma unroll
        for (int ds = 0; ds < 4; ++ds)
#pragma unroll
            for (int j = 0; j < 8; ++j) x[ds][j] *= 0.17677669529663687f * LOG2E;
    }
    n1 = 0.f; n2 = 0.f;
#pragma unroll
    for (int ds = 0; ds < 4; ++ds) {
        v4u w;
#pragma unroll
        for (int p = 0; p < 4; ++p) { w[p] = cvtpk(x[ds][2 * p], x[ds][2 * p + 1]); const float r0 = __uint_as_float(w[p] << 16), r1 = __uint_as_float(w[p] & 0xffff0000u); if (ds < 2) n1 += r0 * r0 + r1 * r1; else n2 += r0 * r0 + r1 * r1; }
        qf[ds] = __builtin_bit_cast(bf16x8, w);
    }
    n1 += __shfl_xor(n1, 32); n2 += __shfl_xor(n2, 32);
}

constexpr int AT2_STR = 144, AT2_TILE = 64 * AT2_STR, AT2_BUF = 2 * AT2_TILE;
#define AT_FADD(acc, x) ((acc) += (x))
template <bool DIFF>
__device__ __forceinline__ void attn_unit(const Args& a, int l, int b, int hq, int qb, LAS unsigned char* lds, int tid_in) {
    int tid = tid_in; asm volatile("" : "+v"(tid));
    const int lane = tid & 63, wave = __builtin_amdgcn_readfirstlane(tid >> 6), r32 = lane & 31, hi = lane >> 5;
    const bf16* Z = (const bf16*)(a.ws + WS_Z);
    const int kcol = DIFF ? 3072 + hq * 64 : 1280 + hq * 64, qcol = DIFF ? 2816 + hq * 64 : 1024 + hq * 128;
    const bf16* VT = DIFF ? (const bf16*)(a.ws + WS_VDT) + (size_t)((b * 4 + hq) * 64) * NKEY : (const bf16*)(a.ws + WS_VGT) + (size_t)((b * 2 + hq) * 64) * NKEY;
    const int nt = (qb == 0) ? CTX / 64 : NKEY / 64;
    const int kq = qb * 256 + wave * 32 + r32, mq = zrow_of_key(b, kq);
    LAS unsigned char* qlds = lds + 3 * AT2_BUF + wave * 8192 + lane * 16;
    bf16x8 qf[DIFF ? 4 : 8];
#pragma unroll
    for (int ds = 0; ds < (DIFF ? 4 : 8); ++ds) qf[ds] = *(const GAS bf16x8*)(Z + (size_t)mq * INW + qcol + 16 * ds + 8 * hi);
    float qn1, qn2, qn3 = 0.f, qn4 = 0.f;
    {
        const bool latq = qb != 0; const int tq = kq - CTX;
        bf16x8 (&qa)[4] = *reinterpret_cast<bf16x8 (*)[4]>(&qf[0]);
        q_prepare<DIFF>(a, l, qa, latq, tq, hi, qn1, qn2);
        if (!DIFF) { bf16x8 (&qbv)[4] = *reinterpret_cast<bf16x8 (*)[4]>(&qf[DIFF ? 0 : 4]); q_prepare<false>(a, l, qbv, latq, tq, hi, qn3, qn4); }
    }
#define AT_Q(i) (qf[(i) & (DIFF ? 3 : 7)])
    const unsigned* kmaxw = (const unsigned*)(a.ws + WS_CTL) + CW_KMAX + l * 64;
    float nb;
    if (!DIFF) {
        const float km = __uint_as_float(__hip_atomic_load(kmaxw + b * 2 + hq, RLX_AGENT));
        nb = -sqrtf(fmaxf(qn1 + qn2, qn3 + qn4)) * sqrtf(km);
    } else {
        const float km1 = __uint_as_float(__hip_atomic_load(kmaxw + 8 + (b * 4 + hq) * 2, RLX_AGENT)), km2 = __uint_as_float(__hip_atomic_load(kmaxw + 8 + (b * 4 + hq) * 2 + 1, RLX_AGENT));
        nb = -fmaxf(sqrtf(qn1) * sqrtf(km1), sqrtf(qn2) * sqrtf(km2));
    }
    f32x16 nbv;
#pragma unroll
    for (int i = 0; i < 16; ++i) nbv[i] = nb;
    f32x16 o1[2], o2[2];
#pragma unroll
    for (int i = 0; i < 2; ++i) { o1[i] = (f32x16){}; o2[i] = (f32x16){}; }
    float l1 = 0.f, l2 = 0.f;
    const int srow = tid >> 3, sch = tid & 7;
    const unsigned voffK = (unsigned)((srow * INW + kcol + 8 * sch) * 2), voffV = (unsigned)((srow * NKEY + 8 * sch) * 2);
    const unsigned char* vt = (const unsigned char*)VT;
    const int wK = srow * AT2_STR + sch * 16, wV = AT2_TILE + srow * AT2_STR + (sch >> 1) * 32 + (sch & 1) * 8;
    const int rK = r32 * AT2_STR + hi * 16, rV = AT2_TILE + r32 * AT2_STR + hi * 16;
#define AT_GLOAD(t) do { const unsigned char* zt_ = (const unsigned char*)Z + (size_t)zrow_of_key(b, (t) * 64) * (INW * 2); kr = *(const GAS v4u*)(zt_ + voffK); vr = *(const GAS v4u*)(vt + (size_t)(t) * 128 + voffV); } while (0)
#define AT_LWRITE(slot) do { *(LAS v4u*)(lds + (slot) * AT2_BUF + wK) = kr; LAS u32x2* vd_ = (LAS u32x2*)(lds + (slot) * AT2_BUF + wV); vd_[0] = (u32x2){vr.x, vr.y}; vd_[2] = (u32x2){vr.z, vr.w}; } while (0)
#define AT_KFRAGS(dst, slot, kh) do { _Pragma("unroll") for (int ds_ = 0; ds_ < 4; ++ds_) dst[ds_] = *(const LAS bf16x8*)(lds + (slot) * AT2_BUF + rK + (kh) * 32 * AT2_STR + ds_ * 32); } while (0)
#define AT_VFRAGS(dst, slot, kh) do { _Pragma("unroll") for (int dh_ = 0; dh_ < 2; ++dh_) _Pragma("unroll") for (int sp_ = 0; sp_ < 2; ++sp_) dst[dh_ * 2 + sp_] = *(const LAS bf16x8*)(lds + (slot) * AT2_BUF + rV + dh_ * 32 * AT2_STR + ((kh) * 2 + sp_) * 32); } while (0)
#define AT_DOT(acc, w) acc = __builtin_amdgcn_fdot2_f32_bf16(__builtin_bit_cast(bf16x2_t, (unsigned)(w)), __builtin_bit_cast(bf16x2_t, 0x3F803F80u), acc, false)
#define AT_PACK(dst, s_, lsum) do { _Pragma("unroll") for (int sp_ = 0; sp_ < 2; ++sp_) { v4u w_; w_.x = cvtpk(s_[8 * sp_], s_[8 * sp_ + 1]); w_.y = cvtpk(s_[8 * sp_ + 2], s_[8 * sp_ + 3]); w_.z = cvtpk(s_[8 * sp_ + 4], s_[8 * sp_ + 5]); w_.w = cvtpk(s_[8 * sp_ + 6], s_[8 * sp_ + 7]); AT_DOT(lsum, w_.x); AT_DOT(lsum, w_.y); AT_DOT(lsum, w_.z); AT_DOT(lsum, w_.w); dst[sp_] = __builtin_bit_cast(bf16x8, w_); } } while (0)
#define AT_HALF(slot, kh, nslot, nkh, have_next) do { \
        f32x16 s1_, s2_; \
        if (!DIFF) { s1_ = __builtin_amdgcn_mfma_f32_32x32x16_bf16(kf[0], AT_Q(0), nbv, 0, 0, 0); s1_ = __builtin_amdgcn_mfma_f32_32x32x16_bf16(kf[1], AT_Q(1), s1_, 0, 0, 0); \
                     s2_ = __builtin_amdgcn_mfma_f32_32x32x16_bf16(kf[0], AT_Q(4), nbv, 0, 0, 0); s2_ = __builtin_amdgcn_mfma_f32_32x32x16_bf16(kf[1], AT_Q(5), s2_, 0, 0, 0); \
                     s1_ = __builtin_amdgcn_mfma_f32_32x32x16_bf16(kf[2], AT_Q(2), s1_, 0, 0, 0); s1_ = __builtin_amdgcn_mfma_f32_32x32x16_bf16(kf[3], AT_Q(3), s1_, 0, 0, 0); \
                     s2_ = __builtin_amdgcn_mfma_f32_32x32x16_bf16(kf[2], AT_Q(6), s2_, 0, 0, 0); s2_ = __builtin_amdgcn_mfma_f32_32x32x16_bf16(kf[3], AT_Q(7), s2_, 0, 0, 0); } \
        else { s1_ = __builtin_amdgcn_mfma_f32_32x32x16_bf16(kf[0], AT_Q(0), nbv, 0, 0, 0); s1_ = __builtin_amdgcn_mfma_f32_32x32x16_bf16(kf[1], AT_Q(1), s1_, 0, 0, 0); \
               s2_ = __builtin_amdgcn_mfma_f32_32x32x16_bf16(kf[2], AT_Q(2), nbv, 0, 0, 0); s2_ = __builtin_amdgcn_mfma_f32_32x32x16_bf16(kf[3], AT_Q(3), s2_, 0, 0, 0); } \
        bf16x8 vb_[4]; AT_VFRAGS(vb_, slot, kh); \
        if (have_next) AT_KFRAGS(kf, nslot, nkh); \
        asm volatile("" ::: "memory"); \
        bf16x8 pa1_[2], pa2_[2]; \
        _Pragma("unroll") for (int i_ = 0; i_ < 16; ++i_) { s1_[i_] = __builtin_amdgcn_exp2f(s1_[i_]); } \
        AT_PACK(pa1_, s1_, l1); \
        { _Pragma("unroll") for (int i_ = 0; i_ < 16; ++i_) { s2_[i_] = __builtin_amdgcn_exp2f(s2_[i_]); } AT_PACK(pa2_, s2_, l2); } \
        _Pragma("unroll") for (int dh_ = 0; dh_ < 2; ++dh_) _Pragma("unroll") for (int sp_ = 0; sp_ < 2; ++sp_) { \
            o1[dh_] = __builtin_amdgcn_mfma_f32_32x32x16_bf16(pa1_[sp_], vb_[dh_ * 2 + sp_], o1[dh_], 0, 0, 0); \
            o2[dh_] = __builtin_amdgcn_mfma_f32_32x32x16_bf16(pa2_[sp_], vb_[dh_ * 2 + sp_], o2[dh_], 0, 0, 0); } \
    } while (0)
    v4u kr, vr;
    AT_GLOAD(0); AT_LWRITE(0);
    AT_GLOAD(1); AT_LWRITE(1);
    __syncthreads();
    bf16x8 kf[4];
    AT_KFRAGS(kf, 0, 0);
    int s0 = 0, s1i = 1, s2i = 2;
    for (int kt = 0; kt < nt; ++kt) {
        const bool more1 = kt + 1 < nt, more2 = kt + 2 < nt;
        if (more2) AT_GLOAD(kt + 2);
        AT_HALF(s0, 0, s0, 1, true);
        AT_HALF(s0, 1, s1i, 0, more1);
        if (more2) AT_LWRITE(s2i);
        __syncthreads();
        const int t_ = s0; s0 = s1i; s1i = s2i; s2i = t_;
    }
#undef AT_Q
#undef AT_GLOAD
#undef AT_LWRITE
#undef AT_KFRAGS
#undef AT_VFRAGS
#undef AT_PACK
#undef AT_DOT
#undef AT_HALF
    int le = lane; asm volatile("" : "+v"(le));
    const int r32e = le & 31, hie = le >> 5;
    l1 += __shfl_xor(l1, 32); l2 += __shfl_xor(l2, 32);
    const float inv1 = 1.f / l1;
    GAS bf16* MIX = (GAS bf16*)(a.ws + WS_HN);
    if (!DIFF) {
        const float inv2g = 1.f / l2;
#pragma unroll
        for (int r = 0; r < 16; ++r) {
            const int qi = (r & 3) + 8 * (r >> 2) + 4 * hie;
            const float iv = __shfl(inv1, qi), iw = __shfl(inv2g, qi);
            GAS bf16* op = MIX + (size_t)zrow_of_key(b, qb * 256 + wave * 32 + qi) * 1024 + 256 + hq * 128 + r32e;
            op[0] = (bf16)f2bf(o1[0][r] * iv); op[32] = (bf16)f2bf(o1[1][r] * iv);
            op[64] = (bf16)f2bf(o2[0][r] * iw); op[96] = (bf16)f2bf(o2[1][r] * iw);
            asm volatile("" ::: "memory");
        }
    } else {
        const float lam = __hip_atomic_load((const GAS float*)(a.ws + WS_TAB + TAB_LAM) + l * 2, RLX_AGENT), li = __hip_atomic_load((const GAS float*)(a.ws + WS_TAB + TAB_LAM) + l * 2 + 1, RLX_AGENT);
        const float inv2 = lam / l2;
#pragma unroll
        for (int r = 0; r < 16; ++r) {
            const int qi = (r & 3) + 8 * (r >> 2) + 4 * hie;
            const float iv1 = __shfl(inv1, qi), iv2 = __shfl(inv2, qi);
            o1[0][r] = o1[0][r] * iv1 - o2[0][r] * iv2; o1[1][r] = o1[1][r] * iv1 - o2[1][r] * iv2;
        }
        const float g0 = a.in[I_DFNG][l * 64 + r32e] * (1.f - li), g1 = a.in[I_DFNG][l * 64 + 32 + r32e] * (1.f - li);
#pragma unroll
        for (int r = 0; r < 16; ++r) {
            const int qi = (r & 3) + 8 * (r >> 2) + 4 * hie;
            const float y0 = o1[0][r], y1 = o1[1][r];
            float ss = y0 * y0 + y1 * y1;
#pragma unroll
            for (int ofs = 16; ofs > 0; ofs >>= 1) ss += __shfl_xor(ss, ofs);
            const float rstd = 1.0f / sqrtf(ss * (1.f / 64.f) + 1e-6f);
            GAS bf16* op = MIX + (size_t)zrow_of_key(b, qb * 256 + wave * 32 + qi) * 1024 + 768 + hq * 64 + r32e;
            op[0] = (bf16)f2bf(y0 * rstd * g0); op[32] = (bf16)f2bf(y1 * rstd * g1);
            asm volatile("" ::: "memory");
        }
    }
}

__device__ __forceinline__ void ph_attn(const Args& a, int l, LAS unsigned char* lds, int G, int wave_sg, int i_lo, int i_hi) {
    const int tid = phase_tid();
    const int total = 768 + (l == 0 ? 24 : 0);
    for (int i = i_lo; i < i_hi; ++i) {
        const int L = i * G + (int)blockIdx.x;
        if (L >= total) break;
        bool isdiff; int b, hq, qb;
        if (L < 256) { const int x = L & 7; isdiff = false; b = x >> 1; hq = x & 1; qb = (L >> 3) + 1; }
        else if (L < 768) { const int Lp = L - 256, x = Lp & 7, j = (Lp >> 3) & 31, rep = Lp >> 8; isdiff = true; b = x >> 1; hq = 2 * (x & 1) + rep; qb = j + 1; }
        else if (L < 776) { const int c = L - 768; isdiff = false; b = c >> 1; hq = c & 1; qb = 0; }
        else { const int c = L - 776; isdiff = true; b = c >> 2; hq = c & 3; qb = 0; }
        if (isdiff) attn_unit<true>(a, l, b, hq, qb, lds, tid); else attn_unit<false>(a, l, b, hq, qb, lds, tid);
    }
}
constexpr size_t WS_LAS = WS_REG + 257 * MiB;
constexpr size_t WS_LAG = WS_REG + 323 * MiB;
constexpr int LA_STR = 160;
constexpr int U_QC = 0, U_QD = 64 * LA_STR, U_QX = 128 * LA_STR, U_KB = 176 * LA_STR, U_KD = 224 * LA_STR, U_A = 288 * LA_STR, U_DIR = 352 * LA_STR;
constexpr int LA1_VT_ALT = 16384;
constexpr int U_VT = 2 * U_DIR, U_PART = U_VT + 64 * LA_STR, U_SS = U_PART + 4096;
static_assert(U_SS + 1024 <= RING_BYTES, "LA LDS map");

__device__ __forceinline__ int la_chain(int mixer, int b, int h, int dir) { return ((mixer * 4 + b) * 4 + h) * 2 + dir; }
__device__ __forceinline__ int la_proc_chunk(int tc, int dir) { return dir == 0 ? tc : (tc < 4 ? 3 - tc : 135 - tc); }
__device__ __forceinline__ float bfbits(unsigned short h) { return __uint_as_float((unsigned)h << 16); }
__device__ __forceinline__ unsigned short hwbf(float v) { return (unsigned short)cvtpk(v, 0.f); }
__device__ __forceinline__ void lds_st_bf(LAS unsigned char* p, float v) { *(LAS unsigned short*)p = hwbf(v); }
__device__ __forceinline__ void lds_st_bf2(LAS unsigned char* p0, float v0, LAS unsigned char* p1, float v1) { const unsigned w = cvtpk(v0, v1); *(LAS unsigned short*)p0 = (unsigned short)w; *(LAS unsigned short*)p1 = (unsigned short)(w >> 16); }

struct La2Regs { unsigned short q0[8], q1[8], k0[8], k1[8], v[8]; float gam0, gam1, lb0, lb1; };
template <bool LA3>
__device__ __forceinline__ void la2_fetch(const Args& a, int l, int mixer, int b, int h, int tc, int wave, int lane, La2Regs& R) {
    const GAS bf16* zb = (const GAS bf16*)(a.ws + WS_Z) + (size_t)zrow_of_key(b, tc * 64) * INW + lane;
    const int qc = mixer == 0 ? h * 64 : 1536 + h * 64, kc0 = mixer == 0 ? 256 + h * 64 : 1792 + h * 64, kc1 = mixer == 0 ? 256 + h * 64 : 2048 + h * 64, vc = mixer == 0 ? 512 + h * 64 : 2304 + h * 64;
#pragma unroll
    for (int r = 0; r < 8; ++r) {
        const size_t t0 = (size_t)(8 * wave + r) * INW, t1 = (size_t)(63 - 8 * wave - r) * INW;
        R.k0[r] = zb[t0 + kc0]; R.k1[r] = zb[t1 + kc1]; R.v[r] = zb[t0 + vc];
        if (LA3) { R.q0[r] = zb[t0 + qc]; R.q1[r] = zb[t1 + qc]; }
    }
    R.gam0 = __hip_atomic_load((const GAS float*)(a.ws + WS_TAB + TAB_GAM) + (l * 2 + 0) * 4 + h, RLX_AGENT);
    R.gam1 = __hip_atomic_load((const GAS float*)(a.ws + WS_TAB + TAB_GAM) + (l * 2 + 1) * 4 + h, RLX_AGENT);
    R.lb0 = __hip_atomic_load((const GAS float*)(a.ws + WS_TAB + TAB_LBV) + (l * 2 + 0) * 256 + h * 64 + lane, RLX_AGENT);
    R.lb1 = __hip_atomic_load((const GAS float*)(a.ws + WS_TAB + TAB_LBV) + (l * 2 + 1) * 256 + h * 64 + lane, RLX_AGENT);
}
__device__ __forceinline__ void la2_gen_a(const unsigned short (&k)[8], float gam, float lb, int mixer, int dir, LAS unsigned char* lds, int wave, int lane, float (&la)[8], float (&kv)[8]) {
    const float lgam = __builtin_amdgcn_logf(gam);
    float s = 0.f;
#pragma unroll
    for (int r = 0; r < 8; ++r) {
        const float x = bfbits(k[r]);
        if (mixer == 0) { la[r] = lgam; kv[r] = x; }
        else { const float sg = __builtin_amdgcn_rcpf(1.f + __expf(-x)); la[r] = fmaxf(__builtin_amdgcn_logf(lb + (1.f - lb) * sg), -115.4f); kv[r] = (1.f - lb) * (1.f - sg); }
        s += la[r];
    }
    *(LAS float*)(lds + U_PART + ((dir * 8 + wave) * 64 + lane) * 4) = s;
}
__device__ __forceinline__ void la2_vt(const unsigned short (&v)[8], LAS unsigned char* vtb  , int wave, int lane) {
    *(LAS v4u*)(vtb + lane * LA_STR + wave * 16) = (v4u){(unsigned)v[0] | ((unsigned)v[1] << 16), (unsigned)v[2] | ((unsigned)v[3] << 16), (unsigned)v[4] | ((unsigned)v[5] << 16), (unsigned)v[6] | ((unsigned)v[7] << 16)};
}

__device__ __forceinline__ void la1_item(const Args& a, int l, int mixer, int b, int h, int tc, LAS unsigned char* lds, int tid_in, La2Regs& R, int nxt  , int par  ) {
    int tid = tid_in; asm volatile("" : "+v"(tid));
    const int lane = tid & 63, wave = __builtin_amdgcn_readfirstlane(tid >> 6);
    float la0[8], kv0[8], la1[8], kv1[8];
    la2_gen_a(R.k0, R.gam0, R.lb0, mixer, 0, lds, wave, lane, la0, kv0);
    la2_gen_a(R.k1, R.gam1, R.lb1, mixer, 1, lds, wave, lane, la1, kv1);
    LAS unsigned char* vtb = lds + (par ? LA1_VT_ALT : U_VT);
    la2_vt(R.v, vtb, wave, lane);
    if (nxt >= 0) { const int ch2 = nxt / 132; la2_fetch<false>(a, l, ch2 >> 4, (ch2 >> 2) & 3, ch2 & 3, nxt % 132, wave, lane, R); }
    __syncthreads();
#pragma unroll
    for (int dir = 0; dir < 2; ++dir) {
        float base = 0.f, ctot = 0.f;
#pragma unroll
        for (int w2 = 0; w2 < 8; ++w2) { const float pv = *(const LAS float*)(lds + U_PART + ((dir * 8 + w2) * 64 + lane) * 4); ctot += pv; if (w2 < wave) base += pv; }
        float c = base; float hv[8];
#pragma unroll
        for (int r = 0; r < 8; ++r) { c += dir ? la1[r] : la0[r]; hv[r] = (dir ? kv1[r] : kv0[r]) * __builtin_amdgcn_exp2f(ctot - c); }
        if (dir == 0) *(LAS v4u*)(lds + 0 * U_DIR + lane * LA_STR + wave * 16) = (v4u){cvtpk(hv[0], hv[1]), cvtpk(hv[2], hv[3]), cvtpk(hv[4], hv[5]), cvtpk(hv[6], hv[7])};
        else *(LAS v4u*)(lds + 1 * U_DIR + lane * LA_STR + (7 - wave) * 16) = (v4u){cvtpk(hv[7], hv[6]), cvtpk(hv[5], hv[4]), cvtpk(hv[3], hv[2]), cvtpk(hv[1], hv[0])};
        const size_t idx = (size_t)la_chain(mixer, b, h, dir) * 132 + la_proc_chunk(tc, dir);
        if (wave == 0) ((GAS float*)(a.ws + WS_LAG))[idx * 64 + lane] = __builtin_amdgcn_exp2f(ctot);
    }
    __syncthreads();
    {
        const int r16 = lane & 15, g = lane >> 4, mi = wave & 3;
#pragma unroll
        for (int rep = 0; rep < 4; ++rep) {
            const int dir = rep >> 1, ni = 2 * (wave >> 2) + (rep & 1);
            pg8::f32x4 acc = {0.f, 0.f, 0.f, 0.f};
#pragma unroll
            for (int ks = 0; ks < 2; ++ks) {
                const bf16x8 af = *(const LAS bf16x8*)(vtb + (16 * mi + r16) * LA_STR + ks * 64 + g * 16);
                const bf16x8 bfr = *(const LAS bf16x8*)(lds + dir * U_DIR + (16 * ni + r16) * LA_STR + ks * 64 + g * 16);
                acc = __builtin_amdgcn_mfma_f32_16x16x32_bf16(af, bfr, acc, 0, 0, 0);
            }
            GAS bf16* ST = (GAS bf16*)(a.ws + WS_LAS) + ((size_t)la_chain(mixer, b, h, dir) * 132 + la_proc_chunk(tc, dir)) * 4096;
#pragma unroll
            for (int rg = 0; rg < 4; rg += 2) { const unsigned w = cvtpk(acc[rg], acc[rg + 1]); ST[(16 * mi + 4 * g + rg) * 64 + 16 * ni + r16] = (bf16)w; ST[(16 * mi + 4 * g + rg + 1) * 64 + 16 * ni + r16] = (bf16)(w >> 16); }
        }
    }
}

__device__ __forceinline__ void ph_la_scan(const Args& a, int vcu, int G, int wave_sg) {
    const int tid = phase_tid();
    unsigned* LAS_ = (unsigned*)(a.ws + WS_LAS); const float* LAGp = (const float*)(a.ws + WS_LAG);
    typedef float f32x2s __attribute__((ext_vector_type(2)));
    for (int p = vcu * 512 + tid; p < 64 * 2048; p += G * 512) {
        const int chain = p >> 11, w = p & 2047, d0 = (w & 31) * 2;
        GAS unsigned* st = (GAS unsigned*)LAS_ + (size_t)chain * 132 * 2048 + w;
        const GAS float* gp = (const GAS float*)LAGp + (size_t)chain * 132 * 64 + d0;
        float s0 = 0.f, s1 = 0.f;
        for (int c0 = 0; c0 < 132; c0 += 22) {
            unsigned x[22]; f32x2s g[22];
#pragma unroll
            for (int j = 0; j < 22; ++j) { x[j] = st[(size_t)(c0 + j) * 2048]; g[j] = *(const GAS f32x2s*)(gp + (c0 + j) * 64); }
#pragma unroll
            for (int j = 0; j < 22; ++j) {
                st[(size_t)(c0 + j) * 2048] = pk2(s0, s1);
                s0 = g[j].x * s0 + __uint_as_float(x[j] << 16); s1 = g[j].y * s1 + __uint_as_float(x[j] & 0xffff0000u);
            }
        }
    }
}

__device__ __forceinline__ void la3_gen_b(const unsigned short (&q)[8], const float (&la)[8], const float (&kv)[8], int dir, LAS unsigned char* lds, int wave, int lane) {
    float pr[8];
#pragma unroll
    for (int w2 = 0; w2 < 8; ++w2) pr[w2] = *(const LAS float*)(lds + U_PART + ((dir * 8 + w2) * 64 + lane) * 4);
    const float R1 = pr[0] + pr[1], R2 = R1 + pr[2] + pr[3], R3 = R2 + pr[4] + pr[5];
    float base = 0.f;
#pragma unroll
    for (int w2 = 0; w2 < 8; ++w2) if (w2 < wave) base += pr[w2];
    const int sa = wave >> 1;
    const float Ra = sa == 0 ? 0.f : sa == 1 ? R1 : sa == 2 ? R2 : R3;
    const float Rn = sa == 0 ? R1 : sa == 1 ? R2 : R3;
    LAS unsigned char* T = lds + dir * U_DIR;
    float c = base;
#pragma unroll
    for (int r = 0; r < 8; ++r) {
        const int i = 8 * wave + r;
        c += la[r];
        const float qv = bfbits(q[r]);
        lds_st_bf2(T + U_QC + i * LA_STR + lane * 2, qv * __builtin_amdgcn_exp2f(c), T + U_QD + i * LA_STR + lane * 2, qv * __builtin_amdgcn_exp2f(c - Ra));
        if (sa == 2) lds_st_bf(T + U_QX + (i & 15) * LA_STR + lane * 2, qv * __builtin_amdgcn_exp2f(c - R1));
        if (sa == 3) lds_st_bf2(T + U_QX + (16 + (i & 15)) * LA_STR + lane * 2, qv * __builtin_amdgcn_exp2f(c - R1), T + U_QX + (32 + (i & 15)) * LA_STR + lane * 2, qv * __builtin_amdgcn_exp2f(c - R2));
        if (sa <= 2) lds_st_bf2(T + U_KB + i * LA_STR + lane * 2, kv[r] * __builtin_amdgcn_exp2f(Rn - c), T + U_KD + i * LA_STR + lane * 2, kv[r] * __builtin_amdgcn_exp2f(fminf(Ra - c, 115.4f)));
        else lds_st_bf(T + U_KD + i * LA_STR + lane * 2, kv[r] * __builtin_amdgcn_exp2f(fminf(Ra - c, 115.4f)));
    }
}
__device__ __forceinline__ void la3_item(const Args& a, int l, int mixer, int b, int h, int tc, LAS unsigned char* lds, int tid_in, La2Regs& R, int nmixer, int nb, int nh, int ntc  ) {
    int tid = tid_in; asm volatile("" : "+v"(tid));
    const int lane = tid & 63, wave = __builtin_amdgcn_readfirstlane(tid >> 6);
    const int r16 = lane & 15, g = lane >> 4, ct = wave & 3, mh = wave >> 2;
    v4u sfr[2][2];
#pragma unroll
    for (int dir = 0; dir < 2; ++dir) {
        const GAS bf16* ST = (const GAS bf16*)(a.ws + WS_LAS) + ((size_t)la_chain(mixer, b, h, dir) * 132 + la_proc_chunk(tc, dir)) * 4096;
#pragma unroll
        for (int ks = 0; ks < 2; ++ks) sfr[dir][ks] = *(const GAS v4u*)(ST + (16 * ct + r16) * 64 + 32 * ks + 8 * g);
    }
    const size_t zrow0 = (size_t)zrow_of_key(b, tc * 64);
    unsigned short gx[2][4];
#pragma unroll
    for (int rb = 0; rb < 2; ++rb)
#pragma unroll
        for (int rg = 0; rg < 4; ++rg) gx[rb][rg] = ((const GAS bf16*)(a.ws + WS_Z))[(zrow0 + 16 * (2 * mh + rb) + 4 * g + rg) * INW + (mixer == 0 ? 768 : 2560) + h * 64 + 16 * ct + r16];
    float la0[8], kv0[8], la1[8], kv1[8];
    la2_gen_a(R.k0, R.gam0, R.lb0, mixer, 0, lds, wave, lane, la0, kv0);
    la2_gen_a(R.k1, R.gam1, R.lb1, mixer, 1, lds, wave, lane, la1, kv1);
    la2_vt(R.v, lds + U_VT, wave, lane);
    __syncthreads();
    la3_gen_b(R.q0, la0, kv0, 0, lds, wave, lane);
    la3_gen_b(R.q1, la1, kv1, 1, lds, wave, lane);
    if (ntc >= 0) la2_fetch<true>(a, l, nmixer, nb, nh, ntc, wave, lane, R);
    __syncthreads();
#pragma unroll
    for (int rep = 0; rep < 4; ++rep) {
        const int dir = rep >> 1, blk = wave + 8 * (rep & 1), ba = blk >> 2, bb = blk & 3;
        const LAS unsigned char* T = lds + dir * U_DIR;
        pg8::f32x4 acc = {0.f, 0.f, 0.f, 0.f};
        if (bb <= ba) {
            int qoff, koff;
            if (bb == ba) { qoff = U_QD + 16 * ba * LA_STR; koff = U_KD + 16 * ba * LA_STR; }
            else if (bb == ba - 1) { qoff = U_QD + 16 * ba * LA_STR; koff = U_KB + 16 * bb * LA_STR; }
            else { qoff = U_QX + 16 * (ba == 2 ? 0 : 1 + bb) * LA_STR; koff = U_KB + 16 * bb * LA_STR; }
#pragma unroll
            for (int ks = 0; ks < 2; ++ks) {
                const bf16x8 af = *(const LAS bf16x8*)(T + qoff + r16 * LA_STR + ks * 64 + g * 16);
                const bf16x8 bfr = *(const LAS bf16x8*)(T + koff + r16 * LA_STR + ks * 64 + g * 16);
                acc = __builtin_amdgcn_mfma_f32_16x16x32_bf16(af, bfr, acc, 0, 0, 0);
            }
        }
#pragma unroll
        for (int rg = 0; rg < 4; rg += 2) {
            const int il = 4 * g + rg, jc = 16 * bb + r16;
            const float v0 = (bb < ba || (bb == ba && r16 <= il)) ? acc[rg] : 0.f, v1 = (bb < ba || (bb == ba && r16 <= il + 1)) ? acc[rg + 1] : 0.f;
            LAS unsigned char* p = lds + dir * U_DIR + U_A + (16 * ba + il) * LA_STR + (dir ? 63 - jc : jc) * 2;
            lds_st_bf2(p, v0, p + LA_STR, v1);
        }
    }
    __syncthreads();
    float tot[2][4];
    {
        bf16x8 vf[2];
#pragma unroll
        for (int ks = 0; ks < 2; ++ks) vf[ks] = *(const LAS bf16x8*)(lds + U_VT + (16 * ct + r16) * LA_STR + ks * 64 + g * 16);
#pragma unroll
        for (int rb = 0; rb < 2; ++rb) {
            const int mi = 2 * mh + rb;
            pg8::f32x4 acc0 = {0.f, 0.f, 0.f, 0.f}, acc1 = {0.f, 0.f, 0.f, 0.f};
#pragma unroll
            for (int ks = 0; ks < 2; ++ks) {
                const bf16x8 a0 = *(const LAS bf16x8*)(lds + U_A + (16 * mi + r16) * LA_STR + ks * 64 + g * 16);
                const bf16x8 a1 = *(const LAS bf16x8*)(lds + U_DIR + U_A + (16 * (3 - mi) + r16) * LA_STR + ks * 64 + g * 16);
                acc0 = __builtin_amdgcn_mfma_f32_16x16x32_bf16(a0, vf[ks], acc0, 0, 0, 0);
                acc1 = __builtin_amdgcn_mfma_f32_16x16x32_bf16(a1, vf[ks], acc1, 0, 0, 0);
            }
#pragma unroll
            for (int ks = 0; ks < 2; ++ks) {
                const bf16x8 q0f = *(const LAS bf16x8*)(lds + U_QC + (16 * mi + r16) * LA_STR + ks * 64 + g * 16);
                const bf16x8 q1f = *(const LAS bf16x8*)(lds + U_DIR + U_QC + (16 * (3 - mi) + r16) * LA_STR + ks * 64 + g * 16);
                acc0 = __builtin_amdgcn_mfma_f32_16x16x32_bf16(q0f, __builtin_bit_cast(bf16x8, sfr[0][ks]), acc0, 0, 0, 0);
                acc1 = __builtin_amdgcn_mfma_f32_16x16x32_bf16(q1f, __builtin_bit_cast(bf16x8, sfr[1][ks]), acc1, 0, 0, 0);
            }
#pragma unroll
            for (int rg = 0; rg < 4; ++rg) tot[rb][rg] = acc0[rg] + __shfl_xor(acc1[3 - rg], 48);
#pragma unroll
            for (int rg = 0; rg < 4; ++rg) { float s_ = tot[rb][rg] * tot[rb][rg]; s_ += __shfl_xor(s_, 1); s_ += __shfl_xor(s_, 2); s_ += __shfl_xor(s_, 4); s_ += __shfl_xor(s_, 8);
                if (r16 == 0) *(LAS float*)(lds + U_SS + ((16 * mi + 4 * g + rg) * 4 + ct) * 4) = s_; }
        }
    }
    __syncthreads();
    {
        const float* ng = a.in[mixer == 0 ? I_RETNG : I_HGNG] + l * 64;
        GAS bf16* MIX = (GAS bf16*)(a.ws + WS_HN);
        const int e = 16 * ct + r16;
#pragma unroll
        for (int rb = 0; rb < 2; ++rb)
#pragma unroll
            for (int rg = 0; rg < 4; ++rg) {
                const int row = 16 * (2 * mh + rb) + 4 * g + rg;
                const f32x4 s4 = *(const LAS f32x4*)(lds + U_SS + row * 16);
                const float rstd = __builtin_amdgcn_rsqf(((s4.x + s4.y) + (s4.z + s4.w)) * (1.f / 64.f) + 1e-6f);
                const float gv = bfbits(gx[rb][rg]);
                MIX[(zrow0 + row) * 1024 + (mixer == 0 ? 0 : 512) + h * 64 + e] = (bf16)hwbf(tot[rb][rg] * rstd * ng[e] * gv * __builtin_amdgcn_rcpf(1.f + __expf(-gv)));
            }
    }
}

__device__ __forceinline__ void seam_wait(unsigned* cnt, int G, int wave_sg);
__device__ __forceinline__ void ph_la1(const Args& a, int l, LAS unsigned char* lds, int G, int wave_sg, unsigned* prep_cnt) {
    const int tid = phase_tid(), lane0 = tid & 63, wave0 = __builtin_amdgcn_readfirstlane(tid >> 6);
    constexpr int NI = 32 * 132, HALF = 16 * 132;
    La2Regs R;
    int p = (int)blockIdx.x, par = 0;
    bool waited = false;
    if (p < NI) {
        if (p >= HALF) { seam_wait(prep_cnt, G, wave_sg); waited = true; }
        const int it = p < HALF ? p + HALF : p - HALF, ch = it / 132;
        la2_fetch<false>(a, l, ch >> 4, (ch >> 2) & 3, ch & 3, it % 132, wave0, lane0, R);
    }
    for (; p < NI; p += G) {
        const int it = p < HALF ? p + HALF : p - HALF;
        const int tc = it % 132, ch = it / 132, h = ch & 3, b = (ch >> 2) & 3, mixer = ch >> 4;
        const int np = p + G; const bool nvalid = np < NI;
        const int nit = np < HALF ? np + HALF : np - HALF;
        const bool cross = nvalid && np >= HALF && !waited;
        la1_item(a, l, mixer, b, h, tc, lds, tid, R, (nvalid && !cross) ? nit : -1, par); par ^= 1;
        if (cross) {
            seam_wait(prep_cnt, G, wave_sg); waited = true;
            const int nch = nit / 132;
            la2_fetch<false>(a, l, nch >> 4, (nch >> 2) & 3, nch & 3, nit % 132, wave0, lane0, R);
        }
    }
    if (!waited) seam_wait(prep_cnt, G, wave_sg);
}
__device__ __forceinline__ void ph_la3(const Args& a, int l, LAS unsigned char* lds, int G, int wave_sg) {
    const int tid = phase_tid(), lane0 = tid & 63, wave0 = __builtin_amdgcn_readfirstlane(tid >> 6);
    const int tc0 = (l == 0) ? 0 : 4, ntc = 132 - tc0, total = 32 * ntc;
    La2Regs R;
    int it = (int)blockIdx.x;
    if (it < total) { const int ch = it / ntc; la2_fetch<true>(a, l, ch >> 4, (ch >> 2) & 3, ch & 3, tc0 + it % ntc, wave0, lane0, R); }
    for (; it < total; it += G) {
        const int tc = tc0 + it % ntc, ch = it / ntc, h = ch & 3, b = (ch >> 2) & 3, mixer = ch >> 4;
        const int nx = it + G; const int nch = nx / ntc;
        la3_item(a, l, mixer, b, h, tc, lds, tid, R, nch >> 4, (nch >> 2) & 3, nch & 3, nx < total ? tc0 + nx % ntc : -1);
    }
}
__device__ __forceinline__ void transpose_item(const float* W, int K, int N, bf16* WT, int row_off, LAS float* scr, int item, int lane) {
    const int nblk = N / 32, kb = item / nblk, nb = item % nblk, k0 = 64 * kb, n0 = 32 * nb;
    {
        f32x4 t[8];
#pragma unroll
        for (int i = 0; i < 8; ++i) t[i] = *(const GAS f32x4*)(W + (size_t)(k0 + 8 * i + (lane >> 3)) * N + n0 + 4 * (lane & 7));
#pragma unroll
        for (int i = 0; i < 8; ++i) { LAS float* d = scr + (8 * i + (lane >> 3)) * 33 + 4 * (lane & 7); d[0] = t[i].x; d[1] = t[i].y; d[2] = t[i].z; d[3] = t[i].w; }
    }
    LDS_WAIT(); asm volatile("" ::: "memory");
    const int c = lane & 7;
#pragma unroll
    for (int j = 0; j < 4; ++j) { const int n = (lane >> 3) + 8 * j; const LAS float* s = scr + (8 * c) * 33 + n;
        v4u o; o.x = pk2(s[0 * 33], s[1 * 33]); o.y = pk2(s[2 * 33], s[3 * 33]); o.z = pk2(s[4 * 33], s[5 * 33]); o.w = pk2(s[6 * 33], s[7 * 33]);
        *(GAS v4u*)(WT + (size_t)(row_off + n0 + n) * K + k0 + 8 * c) = o; }
    LDS_WAIT(); asm volatile("" ::: "memory");
}

__device__ __forceinline__ void seam_publish(unsigned* cnt, int wave_sg) {
    asm volatile("s_waitcnt vmcnt(0)" ::: "memory");
    __syncthreads();
    if (wave_sg == 0 && __builtin_amdgcn_mbcnt_hi(~0u, __builtin_amdgcn_mbcnt_lo(~0u, 0u)) == 0u) {
        __builtin_amdgcn_fence(__ATOMIC_RELEASE, "agent");
        asm volatile("s_waitcnt vmcnt(0)" ::: "memory");
        (void)__hip_atomic_fetch_add(cnt, 1u, __ATOMIC_RELAXED, __HIP_MEMORY_SCOPE_AGENT);
    }
}
__device__ __forceinline__ void seam_wait(unsigned* cnt, int G, int wave_sg) {
    if (wave_sg == 0 && __builtin_amdgcn_mbcnt_hi(~0u, __builtin_amdgcn_mbcnt_lo(~0u, 0u)) == 0u) {
        unsigned sp = 0u;
        while (__hip_atomic_load(cnt, __ATOMIC_RELAXED, __HIP_MEMORY_SCOPE_AGENT) < (unsigned)G && ++sp < (1u << 20)) __builtin_amdgcn_s_sleep(2);
        __builtin_amdgcn_fence(__ATOMIC_ACQUIRE, "agent");
        asm volatile("s_waitcnt vmcnt(0)" ::: "memory");
    }
    __syncthreads();
}

__device__ __forceinline__ void ph_prologue(const Args& a, LAS unsigned char* lds, int vcu, int G, int wave_sg) {
    const int tid = phase_tid(), lane = tid & 63, wave = __builtin_amdgcn_readfirstlane(tid >> 6);
    unsigned char* ws = a.ws;
    LAS float* sl = (LAS float*)lds;
    for (int i = tid; i < 5 * 1024; i += 512) { const float v = i < 4096 ? a.in[I_C][i] : a.in[I_CCTX][i - 4096]; sl[i] = siluf(v); }
    __syncthreads();
    {
        float* modvp = (float*)(ws + WS_MISC + MISC_MODVP);
        for (int gid = vcu * 512 + tid; gid < 8 * 12288; gid += G * 512) {
            const int kq = gid / 12288, rem = gid % 12288, l = rem / 6144, n = rem % 6144;
            const float* w = a.in[I_WMOD] + ((size_t)l * 1024 + kq * 128) * 6144 + n;
            float acc[5];
#pragma unroll
            for (int s = 0; s < 5; ++s) acc[s] = 0.f;
#pragma unroll 8
            for (int k = 0; k < 128; ++k) { const float wv = w[(size_t)k * 6144];
#pragma unroll
                for (int s = 0; s < 5; ++s) acc[s] += sl[s * 1024 + kq * 128 + k] * wv; }
#pragma unroll
            for (int s = 0; s < 5; ++s) modvp[(size_t)kq * 61440 + (size_t)(l * 5 + s) * 6144 + n] = acc[s];
        }
    }
    {
        float* hc = (float*)(ws + WS_TAB + TAB_ROPE_HC); float* hs = (float*)(ws + WS_TAB + TAB_ROPE_HS);
        float* dc = (float*)(ws + WS_TAB + TAB_ROPE_DC); float* ds = (float*)(ws + WS_TAB + TAB_ROPE_DS);
        for (int gid = vcu * 512 + tid; gid < SEQ * 32; gid += G * 512) {
            const int t = gid >> 5, i = gid & 31, j = i & 15;
            const float pos = (i < 16) ? (float)(t >> 6) : (float)(t & 63);
            const float ang = pos * powf(10000.f, -(float)j / 16.f);
            hc[gid] = cosf(ang); hs[gid] = sinf(ang);
        }
        for (int gid = vcu * 512 + tid; gid < SEQ * 16; gid += G * 512) {
            const int t = gid >> 4, i = gid & 15, j = i & 7;
            const float pos = (i < 8) ? (float)(t >> 6) : (float)(t & 63);
            const float ang = pos * powf(10000.f, -(float)j / 8.f);
            dc[gid] = cosf(ang); ds[gid] = sinf(ang);
        }
        if (vcu == 0) {
            float* lbv = (float*)(ws + WS_TAB + TAB_LBV); float* gam = (float*)(ws + WS_TAB + TAB_GAM); float* lam = (float*)(ws + WS_TAB + TAB_LAM);
            for (int gid = tid; gid < 1024; gid += 512) {
                const int l = gid >> 9, dir = (gid >> 8) & 1, w = gid & 255;
                const float x0 = a.in[I_HGLB][(dir * 2 + 0) * 256 + w], x1 = a.in[I_HGLB][(dir * 2 + 1) * 256 + w];
                const float mx = fmaxf(x0, x1), e0 = expf(x0 - mx), e1 = expf(x1 - mx);
                lbv[(l * 2 + dir) * 256 + w] = (l == 0) ? 0.f : e1 / (e0 + e1);
            }
            if (tid < 16) gam[tid] = 1.f / (1.f + expf(-a.in[I_RETDL][tid]));
            if (tid < 2) {
                const int l = tid; float s01 = 0.f, s23 = 0.f;
                for (int d = 0; d < 32; ++d) { s01 += a.in[I_DFLAM][(l * 4 + 0) * 32 + d] * a.in[I_DFLAM][(l * 4 + 1) * 32 + d]; s23 += a.in[I_DFLAM][(l * 4 + 2) * 32 + d] * a.in[I_DFLAM][(l * 4 + 3) * 32 + d]; }
                const float li = 0.8f - 0.6f * expf(-0.3f * (float)l);
                lam[l * 2] = expf(s01) - expf(s23) + li; lam[l * 2 + 1] = li;
            }
        }
    }
    seam_publish((unsigned*)(ws + WS_CTL) + CW_PRORDY, wave_sg);
    {
        LAS float* scr = (LAS float*)(lds + wave * 16384);
        const int gw = vcu * NWAVES + wave, NGW = G * NWAVES;
        constexpr int I_IN = (1024 / 64) * (INW / 32), I_OUT = (1024 / 64) * (1024 / 32);
        for (int it = gw; it < 2 * (I_IN + I_OUT); it += NGW) {
            const int l = it / (I_IN + I_OUT); int r = it % (I_IN + I_OUT);
            if (r < I_IN) transpose_item(a.in[I_WIN] + (size_t)l * 1024 * INW, 1024, INW, (bf16*)(ws + WS_WIN) + (size_t)l * INW * 1024, 0, scr, r, lane);
            else transpose_item(a.in[I_WOUT] + (size_t)l * 1024 * 1024, 1024, 1024, (bf16*)(ws + WS_WOUT) + (size_t)l * 1024 * 1024, 0, scr, r - I_IN, lane);
        }
    }
}

__device__ __forceinline__ float modv_from_partials(const Args& a, int idx  ) {
    const GAS float* pp = (const GAS float*)(a.ws + WS_MISC + MISC_MODVP) + idx;
    float v = a.in[I_BMOD][(idx / 30720) * 6144 + idx % 6144];
#pragma unroll
    for (int kq = 0; kq < 8; ++kq) v += pp[(size_t)kq * 61440];
    return v;
}
__device__ __forceinline__ void moe_block_prefix(const Args& a, int l, LAS unsigned char* lds, int tid) {
    volatile LAS int* pb = (volatile LAS int*)(lds + LDS_PB_OFF);
    if (tid < 64) {
        const int c = (tid < NE) ? __hip_atomic_load((const int*)(a.ws + WS_CTL) + CW_CNT + l * NE + tid, RLX_AGENT) : 0;
        int nb = (c + 255) >> 8, incl = nb;
#pragma unroll
        for (int o = 1; o < 32; o <<= 1) { const int t = __shfl_up(incl, o); if ((tid & 63) >= o) incl += t; }
        if (tid < NE) { pb[tid] = incl - nb; pb[64 + tid] = c; }
        if (tid == NE - 1) pb[NE] = incl;
    }
    __syncthreads();
}
__device__ __forceinline__ bf16* xr_row(const Args& a, int m) { return (bf16*)(a.ws + WS_XR16) + (size_t)m * 1024; }
__device__ __forceinline__ f32x4 bf4_to_f32(u32x2 w) { return (f32x4){__uint_as_float(w.x << 16), __uint_as_float(w.x & 0xffff0000u), __uint_as_float(w.y << 16), __uint_as_float(w.y & 0xffff0000u)}; }
struct CombIdx { int e0, e1, p0, p1; float w0, w1; };
struct CombDat { u32x2 x[4]; u32x2 y0[4], y1[4]; };
__device__ __forceinline__ void comb_idx(const Args& a, int m, CombIdx& I) {
    const int* eidp = (const int*)(a.ws + WS_MISC + MISC_EID); const int* posidx = (const int*)(a.ws + WS_MISC + MISC_POSIDX); const float* gw = (const float*)(a.ws + WS_MISC + MISC_GW);
    I.e0 = __hip_atomic_load(eidp + 2 * m, RLX_AGENT); I.e1 = __hip_atomic_load(eidp + 2 * m + 1, RLX_AGENT);
    I.p0 = __hip_atomic_load(posidx + 2 * m, RLX_AGENT); I.p1 = __hip_atomic_load(posidx + 2 * m + 1, RLX_AGENT);
    I.w0 = __hip_atomic_load(gw + 2 * m, RLX_AGENT); I.w1 = __hip_atomic_load(gw + 2 * m + 1, RLX_AGENT);
}
__device__ __forceinline__ void comb_dat(const Args& a, int m, int lane, LAS unsigned char* lds, const CombIdx& I, CombDat& D) {
    const volatile LAS int* pb = (const volatile LAS int*)(lds + LDS_PB_OFF);
    const int r0 = pb[I.e0] * 256 + I.p0, r1 = pb[I.e1] * 256 + I.p1;
    const GAS u32x2* xr = (const GAS u32x2*)xr_row(a, m) + lane;
    const GAS u32x2* y0 = (const GAS u32x2*)((const bf16*)(a.ws + WS_XS) + (size_t)r0 * 1024) + lane;
    const GAS u32x2* y1 = (const GAS u32x2*)((const bf16*)(a.ws + WS_XS) + (size_t)r1 * 1024) + lane;
#pragma unroll
    for (int j = 0; j < 4; ++j) { D.x[j] = xr[64 * j]; D.y0[j] = y0[64 * j]; D.y1[j] = y1[64 * j]; }
}
__device__ __forceinline__ void comb_apply(const Args& a, int lprev, int m, int lane, const CombIdx& I, const CombDat& D, f32x4 (&v)[4]) {
    const GAS f32x4* g2 = (const GAS f32x4*)((const float*)(a.ws + WS_TAB + TAB_MODV) + (size_t)(lprev * 5 + mods_of_tok(m)) * 6144 + 5120) + lane;
#pragma unroll
    for (int j = 0; j < 4; ++j) v[j] = bf4_to_f32(D.x[j]) + g2[64 * j] * (bf4_to_f32(D.y0[j]) * I.w0 + bf4_to_f32(D.y1[j]) * I.w1);
}
__device__ __forceinline__ void ph_rowprep(const Args& a, int l, LAS unsigned char* lds, int vcu, int G, int wave_sg) {
    const int tid = phase_tid(), lane = tid & 63, wave = __builtin_amdgcn_readfirstlane(tid >> 6);
    const int gw = vcu * NWAVES + wave, NGW = G * NWAVES;
    GAS float* modv = (GAS float*)(a.ws + WS_TAB + TAB_MODV);
    LAS float* mvl = (LAS float*)lds;
    if (l == 0) {
        seam_wait((unsigned*)(a.ws + WS_CTL) + CW_PRORDY, G, wave_sg);
        for (int i = vcu * 512 + tid; i < 61440; i += G * 512) modv[i] = modv_from_partials(a, i);
#pragma unroll 1
        for (int q0 = 0; q0 < 20; q0 += 4) {
            float tv[4];
#pragma unroll
            for (int q = 0; q < 4; ++q) { const int i = tid + 512 * (q0 + q); tv[q] = modv_from_partials(a, (i / 2048) * 6144 + (i % 2048)); }
#pragma unroll
            for (int q = 0; q < 4; ++q) mvl[tid + 512 * (q0 + q)] = tv[q];
        }
    } else {
        float tv[20];
#pragma unroll
        for (int q = 0; q < 20; ++q) { const int i = tid + 512 * q; tv[q] = modv[(size_t)(l * 5 + i / 2048) * 6144 + (i % 2048)]; }
#pragma unroll
        for (int q = 0; q < 20; ++q) mvl[tid + 512 * q] = tv[q];
    }
    __syncthreads();
    bf16* HN = (bf16*)(a.ws + WS_HN);
    const float* ng = a.in[I_N1G] + l * 1024;
    CombIdx Ia, Ib;
    if (l != 0) { const int f0 = gw < NTOK ? gw : 0, f1 = f0 + NGW < NTOK ? f0 + NGW : f0; comb_idx(a, f0, Ia); comb_idx(a, f1, Ib); }
    for (int m0 = gw; m0 < NTOK; m0 += 2 * NGW) {
        const int m1 = m0 + NGW; const bool two = m1 < NTOK;
        f32x4 va[4], vb[4];
        if (l == 0) {
            const GAS f32x4* xa = (const GAS f32x4*)(m0 < NLAT ? a.in[I_X] + (size_t)m0 * 1024 : a.in[I_CTX] + (size_t)(m0 - NLAT) * 1024) + lane;
            const int m1c = two ? m1 : m0;
            const GAS f32x4* xb = (const GAS f32x4*)(m1c < NLAT ? a.in[I_X] + (size_t)m1c * 1024 : a.in[I_CTX] + (size_t)(m1c - NLAT) * 1024) + lane;
#pragma unroll
            for (int j = 0; j < 4; ++j) { va[j] = xa[64 * j]; vb[j] = xb[64 * j]; }
        } else {
            const int m1c = two ? m1 : m0;
            CombDat Da, Db; comb_dat(a, m0, lane, lds, Ia, Da); comb_dat(a, m1c, lane, lds, Ib, Db);
            CombIdx Na, Nb;
            { const int n0 = m0 + 2 * NGW < NTOK ? m0 + 2 * NGW : m0, n1 = n0 + NGW < NTOK ? n0 + NGW : n0; comb_idx(a, n0, Na); comb_idx(a, n1, Nb); }
            comb_apply(a, l - 1, m0, lane, Ia, Da, va); comb_apply(a, l - 1, m1c, lane, Ib, Db, vb);
            Ia = Na; Ib = Nb;
            GAS u32x2* xw = (GAS u32x2*)xr_row(a, m0) + lane;
#pragma unroll
            for (int j = 0; j < 4; ++j) xw[64 * j] = (u32x2){pk2(va[j].x, va[j].y), pk2(va[j].z, va[j].w)};
            if (two) { GAS u32x2* xw1 = (GAS u32x2*)xr_row(a, m1) + lane;
#pragma unroll
                for (int j = 0; j < 4; ++j) xw1[64 * j] = (u32x2){pk2(vb[j].x, vb[j].y), pk2(vb[j].z, vb[j].w)}; }
        }
#pragma unroll
        for (int rr = 0; rr < 2; ++rr) {
            if (rr == 1 && !two) break;
            const int m = rr ? m1 : m0; const int s = mods_of_tok(m);
            float ss = 0.f;
#pragma unroll
            for (int j = 0; j < 4; ++j) { const f32x4 t = rr ? vb[j] : va[j]; ss += (t.x * t.x + t.y * t.y) + (t.z * t.z + t.w * t.w); }
            const float rstd = 1.0f / sqrtf(wave_sum(ss) * (1.f / 1024.f) + 1e-6f);
            GAS u32x2* o8 = (GAS u32x2*)(HN + (size_t)m * 1024) + lane;
#pragma unroll
            for (int j = 0; j < 4; ++j) {
                const int k = 4 * lane + 256 * j;
                const f32x4 g = *(const f32x4*)(ng + k), sh = *(const LAS f32x4*)(mvl + s * 2048 + k), sc = *(const LAS f32x4*)(mvl + s * 2048 + 1024 + k);
                const f32x4 h = (rr ? vb[j] : va[j]) * rstd * g * (sc + 1.0f) + sh;
                u32x2 w; w.x = pk2(h.x, h.y); w.y = pk2(h.z, h.w); o8[64 * j] = w;
            }
        }
    }
    __syncthreads();
}

__device__ __forceinline__ void ph_route(const Args& a, int l, int nrows, LAS unsigned char* lds, int vcu, int G, int wave_sg) {
    const int tid = phase_tid(), lane = tid & 63, wave = __builtin_amdgcn_readfirstlane(tid >> 6);
    const int gw = vcu * NWAVES + wave, NGW = G * NWAVES;
    const GAS float* modv = (const GAS float*)(a.ws + WS_TAB + TAB_MODV);
    LAS float* mvl = (LAS float*)lds;
    LAS float* acf = (LAS float*)(lds + 40960);
    LAS float* p2 = (LAS float*)(lds + 61440);
    LAS float* part = (LAS float*)(lds + 63488);
    const float* ng = a.in[I_N2G] + l * 1024;
    {
        float tv[20];
#pragma unroll
        for (int q = 0; q < 20; ++q) { const int i = tid + 512 * q; tv[q] = modv[(size_t)(l * 5 + i / 2048) * 6144 + 3072 + (i % 2048)]; }
#pragma unroll
        for (int q = 0; q < 20; ++q) mvl[tid + 512 * q] = tv[q];
    }
    __syncthreads();
    for (int i = tid; i < 5 * 1024; i += 512) acf[i] = ng[i & 1023] * (1.f + mvl[(i >> 10) * 2048 + 1024 + (i & 1023)]);
    {
        const int e = lane & 31, kp = lane >> 5;
        float acc[5];
#pragma unroll
        for (int s = 0; s < 5; ++s) acc[s] = 0.f;
#pragma unroll 1
        for (int k0 = wave * 128 + kp; k0 < wave * 128 + 128; k0 += 64) {
            float rwv[32];
#pragma unroll
            for (int u = 0; u < 32; ++u) rwv[u] = a.in[I_RW][(size_t)(k0 + 2 * u) * NE + e];
#pragma unroll
            for (int u = 0; u < 32; ++u)
#pragma unroll
                for (int s = 0; s < 5; ++s) acc[s] += mvl[s * 2048 + k0 + 2 * u] * rwv[u];
        }
#pragma unroll
        for (int s = 0; s < 5; ++s) { acc[s] += __shfl_xor(acc[s], 32); if (lane < 32) part[wave * 160 + s * 32 + e] = acc[s]; }
    }
    __syncthreads();
    if (tid < 160) { float v = 0.f;
#pragma unroll
        for (int w = 0; w < 8; ++w) v += part[w * 160 + tid];
        p2[320 + tid] = v; }
    __syncthreads();
    bf16* HN = (bf16*)(a.ws + WS_HN);
    for (int m = gw; m < nrows; m += NGW) {
        const int s = mods_of_tok(m);
        const GAS u32x2* xr = (const GAS u32x2*)xr_row(a, m) + lane;
        f32x4 v[4]; float ss = 0.f;
#pragma unroll
        for (int j = 0; j < 4; ++j) { v[j] = bf4_to_f32(xr[64 * j]); ss += (v[j].x * v[j].x + v[j].y * v[j].y) + (v[j].z * v[j].z + v[j].w * v[j].w); }
        const float rstd = 1.0f / sqrtf(wave_sum(ss) * (1.f / 1024.f) + 1e-6f);
        GAS u32x2* o8 = (GAS u32x2*)(HN + (size_t)m * 1024) + lane;
#pragma unroll
        for (int j = 0; j < 4; ++j) {
            const int k = 4 * lane + 256 * j;
            const f32x4 ac = *(const LAS f32x4*)(acf + s * 1024 + k), sh = *(const LAS f32x4*)(mvl + s * 2048 + k);
            const f32x4 h = v[j] * rstd * ac + sh;
            u32x2 w; w.x = pk2(h.x, h.y); w.y = pk2(h.z, h.w); o8[64 * j] = w;
        }
    }
    int* cnt = (int*)(a.ws + WS_CTL) + CW_CNT + l * NE;
    int* eid = (int*)(a.ws + WS_MISC + MISC_EID); float* gwp = (float*)(a.ws + WS_MISC + MISC_GW); int* posidx = (int*)(a.ws + WS_MISC + MISC_POSIDX); int* lists = (int*)(a.ws + WS_MISC + MISC_LISTS);
    __syncthreads();
    {
        const int kq = wave & 3, half = wave >> 2;
        int lane2 = tid & 63; asm volatile("" : "+v"(lane2));
        const int tok = lane2 & 31, eh = lane2 >> 5;
        LAS float* wst = (LAS float*)(lds + wave * 2048);
        const int wrow = lane2 >> 3, wcol = 4 * (lane2 & 7);
        LAS unsigned* meet = (LAS unsigned*)(lds + LDSCTL_OFF + 2048) + half;
#pragma unroll 1
        for (int tb = vcu * 2 + half; tb < nrows / 32; tb += G * 2) {
            const int m = tb * 32 + tok, s = mods_of_tok(tb * 32);
            const GAS v4u* xr = (const GAS v4u*)xr_row(a, m) + kq * 32;
            const float* rwq = a.in[I_RW] + (size_t)(kq * 256) * NE;
            float lg[16]; float ss = 0.f;
#pragma unroll
            for (int e = 0; e < 16; ++e) lg[e] = 0.f;
            f32x4 wr[2]; v4u xn[2];
#pragma unroll
            for (int u = 0; u < 2; ++u) wr[u] = *(const f32x4*)(rwq + (size_t)(wrow + 8 * u) * NE + wcol);
#pragma unroll
            for (int u = 0; u < 2; ++u) xn[u] = xr[u];
#pragma unroll 1
            for (int j0 = 0; j0 < 64; j0 += 4) {
#pragma unroll
                for (int u = 0; u < 2; ++u) *(LAS f32x4*)(wst + (wrow + 8 * u) * NE + wcol) = wr[u];
                v4u xc[2];
#pragma unroll
                for (int u = 0; u < 2; ++u) xc[u] = xn[u];
                if (j0 + 4 < 64) {
#pragma unroll
                    for (int u = 0; u < 2; ++u) wr[u] = *(const f32x4*)(rwq + (size_t)(4 * (j0 + 4) + wrow + 8 * u) * NE + wcol);
#pragma unroll
                    for (int u = 0; u < 2; ++u) xn[u] = xr[(j0 + 4) / 2 + u];
                }
#pragma unroll
                for (int u = 0; u < 4; ++u) {
                    const unsigned xw0 = xc[u >> 1][(u & 1) * 2], xw1 = xc[u >> 1][(u & 1) * 2 + 1];
                    const f32x4 x = (f32x4){__uint_as_float(xw0 << 16), __uint_as_float(xw0 & 0xffff0000u), __uint_as_float(xw1 << 16), __uint_as_float(xw1 & 0xffff0000u)};
                    const f32x4 ac = *(const LAS f32x4*)(acf + s * 1024 + kq * 256 + 4 * (j0 + u));
                    ss += (x.x * x.x + x.y * x.y) + (x.z * x.z + x.w * x.w);
#pragma unroll
                    for (int i = 0; i < 4; ++i) {
                        const float t = x[i] * ac[i];
                        const LAS f32x4* wrp = (const LAS f32x4*)(wst + (4 * u + i) * NE + 16 * eh);
#pragma unroll
                        for (int e4 = 0; e4 < 4; ++e4) { const f32x4 w4 = wrp[e4]; lg[4 * e4] += t * w4.x; lg[4 * e4 + 1] += t * w4.y; lg[4 * e4 + 2] += t * w4.z; lg[4 * e4 + 3] += t * w4.w; }
                    }
                }
                asm volatile("s_waitcnt lgkmcnt(0)" ::: "memory");
            }
            LAS float* pp = part + (wave * 64 + lane2) * 17;
#pragma unroll
            for (int e = 0; e < 16; ++e) pp[e] = lg[e];
            pp[16] = ss;
            asm volatile("s_waitcnt lgkmcnt(0)" ::: "memory");
            unsigned tgt = 0;
            if (lane2 == 0) { tgt = (__hip_atomic_fetch_add(meet, 1u, __ATOMIC_RELAXED, __HIP_MEMORY_SCOPE_WORKGROUP) & ~3u) + 4u; }
            tgt = __builtin_amdgcn_readfirstlane(tgt);
            while (__hip_atomic_load(meet, __ATOMIC_RELAXED, __HIP_MEMORY_SCOPE_WORKGROUP) < tgt) __builtin_amdgcn_s_sleep(1);
            asm volatile("" ::: "memory");
            if (kq == 0) {
                float sst = 0.f;
#pragma unroll
                for (int e = 0; e < 16; ++e) lg[e] = 0.f;
#pragma unroll
                for (int q4 = 0; q4 < 4; ++q4) {
                    const LAS float* qp = part + ((half * 4 + q4) * 64 + lane2) * 17;
#pragma unroll
                    for (int e = 0; e < 16; ++e) lg[e] += qp[e];
                    sst += qp[16];
                }
                const float rstd = 1.0f / sqrtf(sst * (1.f / 1024.f) + 1e-6f);
                float sc[16], sel[16];
#pragma unroll
                for (int e = 0; e < 16; ++e) { sc[e] = 1.f / (1.f + expf(-(rstd * lg[e] + p2[320 + s * 32 + 16 * eh + e]))); sel[e] = sc[e] + a.in[I_RB][16 * eh + e]; }
                int bg = 0; float bgs = -INFINITY;
#pragma unroll
                for (int g = 0; g < 4; ++g) {
                    float ta = sel[4 * g], tb2 = -INFINITY;
#pragma unroll
                    for (int i = 1; i < 4; ++i) { const float t = sel[4 * g + i]; if (t > ta) { tb2 = ta; ta = t; } else if (t > tb2) tb2 = t; }
                    const float gs = ta + tb2;
                    if (gs > bgs) { bgs = gs; bg = g; }
                }
                const float obgs = __shfl_xor(bgs, 32);
                const bool win = eh == 0 ? (bgs >= obgs) : (bgs > obgs);
                float s4[4], c4[4];
#pragma unroll
                for (int i = 0; i < 4; ++i) { s4[i] = 0.f; c4[i] = 0.f; }
#pragma unroll
                for (int g = 0; g < 4; ++g)
#pragma unroll
                    for (int i = 0; i < 4; ++i) { s4[i] = (bg == g) ? sel[4 * g + i] : s4[i]; c4[i] = (bg == g) ? sc[4 * g + i] : c4[i]; }
                int i0 = 0, i1 = -1; float fa = s4[0], fb = -INFINITY;
#pragma unroll
                for (int i = 1; i < 4; ++i) { const float t = s4[i]; if (t > fa) { fb = fa; i1 = i0; fa = t; i0 = i; } else if (t > fb) { fb = t; i1 = i; } }
                const float g0 = i0 == 0 ? c4[0] : i0 == 1 ? c4[1] : i0 == 2 ? c4[2] : c4[3];
                const float g1 = i1 == 0 ? c4[0] : i1 == 1 ? c4[1] : i1 == 2 ? c4[2] : c4[3];
                if (win) {
                    const int e0 = (4 * eh + bg) * 4 + i0, e1 = (4 * eh + bg) * 4 + i1;
                    const float inv = 1.f / (g0 + g1);
                    eid[m * 2] = e0; eid[m * 2 + 1] = e1;
                    gwp[m * 2] = g0 * inv; gwp[m * 2 + 1] = g1 * inv;
                    const int ix0 = atomicAdd(&cnt[e0], 1), ix1 = atomicAdd(&cnt[e1], 1);
                    posidx[m * 2] = ix0; posidx[m * 2 + 1] = ix1;
                    lists[(size_t)e0 * LISTCAP + ix0] = m; lists[(size_t)e1 * LISTCAP + ix1] = m;
                }
            }
            asm volatile("s_waitcnt lgkmcnt(0)" ::: "memory");
            if (lane2 == 0) { tgt = (__hip_atomic_fetch_add(meet, 1u, __ATOMIC_RELAXED, __HIP_MEMORY_SCOPE_WORKGROUP) & ~3u) + 4u; }
            tgt = __builtin_amdgcn_readfirstlane(tgt);
            while (__hip_atomic_load(meet, __ATOMIC_RELAXED, __HIP_MEMORY_SCOPE_WORKGROUP) < tgt) __builtin_amdgcn_s_sleep(1);
            asm volatile("" ::: "memory");
        }
    }
    __syncthreads();
    {
        int lane3 = tid & 63; asm volatile("" : "+v"(lane3));
        LAS float* scr = (LAS float*)(lds + 49152 + wave * 8704);
        bf16* WGU = (bf16*)(a.ws + WS_WGU);
        const int remb = (nrows / 32) % (2 * G), nlate = (remb + 1) / 2 <= G / 2 ? (remb + 1) / 2 : 0;
        const int cw0 = vcu < nlate ? NE * 256 : (vcu - nlate) * NWAVES + wave, cnw = (G - nlate) * NWAVES;
        for (int it = cw0; it < NE * 256; it += cnw) {
            const int e = it / 256, item = it % 256, n0 = 32 * (item & 15);
            const float* W = a.in[I_WU] + (size_t)(l * NE + e) * 1024 * FF;
            transpose_item(W, 1024, FF, WGU + (size_t)e * 1024 * 1024, (n0 >> 7) * 256 + (n0 & 127) + 128 - n0, scr, item, lane3);
        }
    }
    __syncthreads();
}

__device__ __forceinline__ void ph_convert_wd(const Args& a, int l, LAS unsigned char* lds, int widx, int nw, int wave_sg) {
    const int tid = phase_tid(), wave = __builtin_amdgcn_readfirstlane(tid >> 6);
    int lane3 = tid & 63; asm volatile("" : "+v"(lane3));
    LAS float* scr = (LAS float*)(lds + 49152 + wave * 8704);
    bf16* WD = (bf16*)(a.ws + WS_WD);
    for (int it = widx + wave; it < NE * 256; it += nw) {
        const int e = it / 256, r = it % 256;
        transpose_item(a.in[I_WD] + (size_t)(l * NE + e) * FF * 1024, FF, 1024, WD + (size_t)e * 1024 * FF, 0, scr, r, lane3);
    }
}

__device__ __forceinline__ void ph_convert_gate(const Args& a, int l, LAS unsigned char* lds, int widx, int nw, int wave_sg) {
    const int tid = phase_tid(), wave = __builtin_amdgcn_readfirstlane(tid >> 6);
    int lane3 = tid & 63; asm volatile("" : "+v"(lane3));
    LAS float* scr = (LAS float*)(lds + 49152 + wave * 8704);
    bf16* WGU = (bf16*)(a.ws + WS_WGU);
    for (int it = widx + wave; it < NE * 256; it += nw) {
        const int e = it / 256, item = it % 256, n0 = 32 * (item & 15);
        const float* W = a.in[I_WG] + (size_t)(l * NE + e) * 1024 * FF;
        transpose_item(W, 1024, FF, WGU + (size_t)e * 1024 * 1024, (n0 >> 7) * 256 + (n0 & 127) - n0, scr, item, lane3);
    }
}

__device__ __forceinline__ void ph_final(const Args& a, LAS unsigned char* lds, int vcu, int G, int wave_sg) {
    const int tid = phase_tid(), lane = tid & 63, wave = __builtin_amdgcn_readfirstlane(tid >> 6);
    const int gw = vcu * NWAVES + wave, NGW = G * NWAVES;
    CombIdx Ia, Ib;
    { const int f0 = gw < NLAT ? gw : 0, f1 = f0 + NGW < NLAT ? f0 + NGW : f0; comb_idx(a, f0, Ia); comb_idx(a, f1, Ib); }
    for (int m0 = gw; m0 < NLAT; m0 += 2 * NGW) {
        const int m1 = m0 + NGW; const bool two = m1 < NLAT; const int m1c = two ? m1 : m0;
        CombDat Da, Db; comb_dat(a, m0, lane, lds, Ia, Da); comb_dat(a, m1c, lane, lds, Ib, Db);
        CombIdx Na, Nb;
        { const int n0 = m0 + 2 * NGW < NLAT ? m0 + 2 * NGW : m0, n1 = n0 + NGW < NLAT ? n0 + NGW : n0; comb_idx(a, n0, Na); comb_idx(a, n1, Nb); }
        f32x4 va[4], vb[4];
        comb_apply(a, 1, m0, lane, Ia, Da, va); comb_apply(a, 1, m1c, lane, Ib, Db, vb);
#pragma unroll
        for (int rr = 0; rr < 2; ++rr) {
            if (rr == 1 && !two) break;
            const int m = rr ? m1 : m0;
            float ss = 0.f;
#pragma unroll
            for (int j = 0; j < 4; ++j) { const f32x4 t = rr ? vb[j] : va[j]; ss += (t.x * t.x + t.y * t.y) + (t.z * t.z + t.w * t.w); }
            const float rstd = 1.0f / sqrtf(wave_sum(ss) * (1.f / 1024.f) + 1e-6f);
            GAS f32x4* xo = (GAS f32x4*)(a.out + (size_t)m * 1024) + lane;
#pragma unroll
            for (int j = 0; j < 4; ++j) xo[64 * j] = (rr ? vb[j] : va[j]) * rstd * *(const f32x4*)(a.in[I_FING] + 4 * lane + 256 * j);
        }
        Ia = Na; Ib = Nb;
    }
}

__global__ void __launch_bounds__(NWAVES * 64, 2) mk_fwd(Args args) {
    extern __shared__ __attribute__((aligned(16))) unsigned char lds_raw[];
    LAS unsigned char* lds = (LAS unsigned char*)lds_raw;
    volatile LAS unsigned* MISC = (volatile LAS unsigned*)(lds + MISC_OFF);
    const int tid = threadIdx.x;
    const int wave_sg = __builtin_amdgcn_readfirstlane(tid >> 6);
    const int G = gridDim.x; const int bx = blockIdx.x; const int vcu = (G % 8 == 0) ? (bx % 8) * (G / 8) + bx / 8 : bx;
    for (int u = tid; u < (LDS_BYTES - LDSCTL_OFF) / 4; u += NWAVES * 64) ((LAS unsigned*)(lds + LDSCTL_OFF))[u] = 0u;
    __syncthreads();
    unsigned char* ws = args.ws;
    XcdBarrier bar = xcd_barrier_post((unsigned*)(ws + WS_CTL) + CW_BAR + args.li * XCD_BAR_WORDS, MISC + 8);
    const int lo = args.ph_lo, hi = args.ph_hi;
#define IN(k) (lo <= (k) && (k) < hi)
#define SEAM(k) do { if (IN(k) && (k) + 1 < hi) xcd_barrier(bar, wave_sg); } while (0)
    if (IN(0)) { ph_prologue(args, lds, vcu, G, wave_sg); }
    for (int l = 0; l < 2; ++l) {
        const int pb = 16 * l;
        Args al = args; { unsigned char* w_ = al.ws; asm volatile("" : "+s"(w_)); al.ws = w_; }
        unsigned char* ws = al.ws;
        const int nrows = (l == 0) ? NTOK : NLAT;
        if (IN(pb + 1)) { ph_rowprep(al, l, lds, vcu, G, wave_sg); } SEAM(pb + 1);
        if (IN(pb + 2)) {
            pg8::Gemm g{(const bf16*)(ws + WS_HN), (const bf16*)(ws + WS_WIN) + (size_t)l * INW * 1024, NTOK, INW, 1024};
            pg8::StaticOrder S; S.init(NTOK, INW, G, (int)blockIdx.x);
            pg8::EpiBf16<0> E{(bf16*)(ws + WS_Z), INW, nullptr, 0, 0, 1.f};
            pg8::gemm_phase<pg8::EpiBf16<0>, pg8::StaticOrder, true, true>(lds, g, S, E, wave_sg);
            {
                const int rem = ((NTOK / 256) * (INW / 256)) % G, bxi = (int)blockIdx.x;
                if (bxi >= rem) ph_convert_wd(al, l, lds, (bxi - rem) * NWAVES, (G - rem) * NWAVES, wave_sg);
            }
        } SEAM(pb + 2);
        if (IN(pb + 3)) { ph_prep(al, l, lds, vcu, G, wave_sg); seam_publish((unsigned*)(ws + WS_CTL) + CW_PREPRDY + l * 64, wave_sg); }
        if (IN(pb + 4)) { ph_la1(al, l, lds, G, wave_sg, (unsigned*)(ws + WS_CTL) + CW_PREPRDY + l * 64); seam_publish((unsigned*)(ws + WS_CTL) + CW_LA1RDY + l * 64, wave_sg); }
        if (IN(pb + 6)) {
#pragma unroll 1
            for (int seg = 0; seg < 2; ++seg) {
                int sg_ = seg; asm volatile("" : "+s"(sg_));
                ph_attn(al, l, lds, G, wave_sg, sg_, sg_ == 0 ? 1 : (1 << 20));
                if (sg_ == 0) {
                    seam_wait((unsigned*)(ws + WS_CTL) + CW_LA1RDY + l * 64, G, wave_sg);
                    ph_la_scan(al, vcu, G, wave_sg);
                    seam_publish((unsigned*)(ws + WS_CTL) + CW_SCANRDY + l * 64, wave_sg);
                }
            }
            seam_wait((unsigned*)(ws + WS_CTL) + CW_SCANRDY + l * 64, G, wave_sg);
            ph_la3(al, l, lds, G, wave_sg);
        } SEAM(pb + 6);
        if (IN(pb + 7)) {
            pg8::Gemm g{(const bf16*)(ws + WS_HN), (const bf16*)(ws + WS_WOUT) + (size_t)l * 1024 * 1024, nrows, 1024, 1024};
            pg8::StaticOrder S; S.init(nrows, 1024, G, (int)blockIdx.x);
            const float* gts = (const float*)(ws + WS_TAB + TAB_MODV) + (size_t)(l * 5) * 6144 + 2048;
            if (l == 0) { EpiRes<false> E{args.in[I_X], args.in[I_CTX], (bf16*)(ws + WS_XR16), gts}; pg8::gemm_phase<EpiRes<false>, pg8::StaticOrder, true, true>(lds, g, S, E, wave_sg); }
            else { EpiRes<true> E{nullptr, nullptr, (bf16*)(ws + WS_XR16), gts}; pg8::gemm_phase<EpiRes<true>, pg8::StaticOrder, true, true>(lds, g, S, E, wave_sg); }
            {
                const int rem = ((nrows / 256) * 4) % G, bxi = (int)blockIdx.x;
                if (bxi >= rem) ph_convert_gate(al, l, lds, (bxi - rem) * NWAVES, (G - rem) * NWAVES, wave_sg);
            }
        } SEAM(pb + 7);
        if (IN(pb + 8)) { ph_route(al, l, nrows, lds, vcu, G, wave_sg); } SEAM(pb + 8);
        if (IN(pb + 10)) {
            moe_block_prefix(al, l, lds, phase_tid());
            volatile LAS int* pbt = (volatile LAS int*)(lds + LDS_PB_OFF);
            pg8::Gemm g{(const bf16*)(ws + WS_HN), (const bf16*)(ws + WS_WGU), NTOK, NE * 1024, 1024};
            MoeOrder S{pbt, G, (int)blockIdx.x, pbt[NE] * 4, (const int*)(ws + WS_MISC + MISC_LISTS)};
            EpiGateUp E{(bf16*)(ws + WS_ACT)};
            pg8::gemm_phase<EpiGateUp, MoeOrder, true, true, true>(lds, g, S, E, wave_sg);
        } SEAM(pb + 10);
        if (IN(pb + 11)) {
            volatile LAS int* pbt = (volatile LAS int*)(lds + LDS_PB_OFF);
            pg8::Gemm g{(const bf16*)(ws + WS_ACT), (const bf16*)(ws + WS_WD), RMAX, NE * 1024, FF};
            MoeOrder S{pbt, G, (int)blockIdx.x, pbt[NE] * 4, (const int*)(ws + WS_MISC + MISC_LISTS)};
            pg8::EpiBf16<0> E{(bf16*)(ws + WS_XS), 1024, nullptr, 1024, 0, 1.f};
            pg8::gemm_phase<pg8::EpiBf16<0>, MoeOrder, true, false>(lds, g, S, E, wave_sg);
        } SEAM(pb + 11);
    }
    if (IN(32)) { ph_final(args, lds, vcu, G, wave_sg); }
#undef IN
#undef SEAM
}
extern "C" void kernel_launch(void* const* d_in, const int* in_sizes, int n_in, void* d_out, int out_size, void* d_ws, size_t ws_size, hipStream_t stream) {
    static int grid = 0;
    if (grid == 0) {
        int dev = 0, cus = 0;
        if (hipGetDevice(&dev) != hipSuccess || hipDeviceGetAttribute(&cus, hipDeviceAttributeMultiprocessorCount, dev) != hipSuccess) { grid = -1; return; }
        if (hipFuncSetAttribute((const void*)mk_fwd, hipFuncAttributeMaxDynamicSharedMemorySize, LDS_BYTES) != hipSuccess) { grid = -1; return; }
        (void)hipGetLastError();
        grid = cus;
    }
    if (grid < 0 || ws_size < 538 * MiB) return;
    (void)hipMemsetAsync((char*)d_ws + WS_CTL, 0, CTL_ZERO_BYTES, stream);
    Args a{};
    for (int i = 0; i < 24; ++i) a.in[i] = (const float*)d_in[i];
    a.out = (float*)d_out; a.ws = (unsigned char*)d_ws;
    a.ph_lo = 0; a.ph_hi = 33; a.li = 0;
    hipLaunchKernelGGL(mk_fwd, dim3(grid), dim3(NWAVES * 64), LDS_BYTES, stream, a);
}
```
